# Optimizing an MI355X kernel written in HIP

```python
import jax, jax.numpy as jnp
from jax import lax
import numpy as np

D_MODEL = 1024
BATCH = 16
SEQ = 4096
DEPTH = 1

HEAD_DIM = 64
N_HEADS_A = 8
N_HEADS_B = 8
WIDTH_A = N_HEADS_A * HEAD_DIM
WIDTH_B = N_HEADS_B * HEAD_DIM
IN_COLS = 3 * WIDTH_A + 3 * WIDTH_B
DILATED_GROUPS = ((128, 1), (512, 4), (2048, 16))
ROPE_THETA = 500000.0
ROT_DIM = HEAD_DIM // 4
Q_BLOCK = 128
N_EXPERTS = 32
TOP_K = 4
D_FF = D_MODEL
SWIGLU_ALPHA = 1.702
SWIGLU_LIMIT = 7.0
EXPERT_BLOCK = 512
NORM_EPS = 1e-5

kernel_name = "hybrid_dilated_stickbreaking_gated_moe"


def rmsnorm(x, g):
    xf = x.astype(jnp.float32)
    y = xf * lax.rsqrt(jnp.mean(xf * xf, axis=-1, keepdims=True) + NORM_EPS)
    return (y * g.astype(jnp.float32)).astype(x.dtype)


def partial_rotary(a, pos):
    half = ROT_DIM // 2
    inv_freq = jnp.float32(ROPE_THETA) ** (-jnp.arange(0, ROT_DIM, 2, dtype=jnp.float32) / ROT_DIM)
    ang = pos.astype(jnp.float32)[:, None] * inv_freq[None, :]
    cos, sin = jnp.cos(ang), jnp.sin(ang)
    af = a.astype(jnp.float32)
    x1, x2, rest = af[..., :half], af[..., half:ROT_DIM], af[..., ROT_DIM:]
    out = jnp.concatenate([x1 * cos - x2 * sin, x2 * cos + x1 * sin, rest], axis=-1)
    return out.astype(a.dtype)


def dilated_group_attn(q, k, v, window, dil):
    Bsz, H, S, Dh = q.shape
    n = window // dil
    span = dil * n
    S_pad = -(-S // span) * span
    L = S_pad // dil
    nb = L // n
    pad = ((0, 0), (0, 0), (0, S_pad - S), (0, 0))

    def to_blocks(a):
        a = jnp.pad(a, pad).reshape(Bsz, H, L, dil, Dh).transpose(0, 1, 3, 2, 4)
        return a.reshape(Bsz, H, dil, nb, n, Dh)

    def with_prev(a):
        prev = jnp.pad(a[:, :, :, :-1], ((0, 0), (0, 0), (0, 0), (1, 0), (0, 0), (0, 0)))
        return jnp.concatenate([prev, a], axis=-2)

    qb = to_blocks(q)
    kk = with_prev(to_blocks(k))
    vv = with_prev(to_blocks(v))
    s = jnp.einsum('bhrnqd,bhrnkd->bhrnqk', qb, kk).astype(jnp.float32) * (HEAD_DIM ** -0.5)
    qi = jnp.arange(n)[:, None]
    ki = jnp.arange(2 * n)[None, :]
    dist = n + qi - ki
    blk = jnp.arange(nb)[:, None, None]
    valid = (dist >= 0) & (dist <= n) & ((blk > 0) | (ki >= n))[...]
    s = jnp.where(valid, s, -jnp.inf)
    m = jnp.max(s, axis=-1)
    p = jnp.exp(s - m[..., None])
    l = jnp.sum(p, axis=-1)
    num = jnp.einsum('bhrnqk,bhrnkd->bhrnqd', p, vv.astype(jnp.float32))
    num = num.reshape(Bsz, H, dil, L, Dh).transpose(0, 1, 3, 2, 4).reshape(Bsz, H, S_pad, Dh)[:, :, :S]
    m = m.reshape(Bsz, H, dil, L).transpose(0, 1, 3, 2).reshape(Bsz, H, S_pad)[:, :, :S]
    l = l.reshape(Bsz, H, dil, L).transpose(0, 1, 3, 2).reshape(Bsz, H, S_pad)[:, :, :S]
    return num, m, l


def dilated_attention(q, k, v):
    outs = [dilated_group_attn(q, k, v, w, d) for (w, d) in DILATED_GROUPS]
    m_all = jnp.max(jnp.stack([o[1] for o in outs], axis=0), axis=0)
    num = sum(o[0] * jnp.exp(o[1] - m_all)[..., None] for o in outs)
    den = sum(o[2] * jnp.exp(o[1] - m_all) for o in outs)
    return num / den[..., None]


def stick_breaking_attention(q, k, v):
    Bsz, H, S, Dh = q.shape
    nq = S // Q_BLOCK
    qb = q.reshape(Bsz, H, nq, Q_BLOCK, Dh).transpose(2, 0, 1, 3, 4)
    spos = jnp.arange(S)
    vf = v.astype(jnp.float32)

    def block(args):
        qblk, i = args
        z = jnp.einsum('bhqd,bhkd->bhqk', qblk, k).astype(jnp.float32) * (HEAD_DIM ** -0.5)
        tpos = i * Q_BLOCK + jnp.arange(Q_BLOCK)
        mask = spos[None, :] < tpos[:, None]
        log_keep = jnp.where(mask, jax.nn.log_sigmoid(-z), 0.0)
        after = lax.cumsum(log_keep, axis=3, reverse=True) - log_keep
        a = jnp.where(mask, jnp.exp(jax.nn.log_sigmoid(z) + after), 0.0)
        return jnp.einsum('bhqk,bhkd->bhqd', a, vf)

    o = lax.map(block, (qb, jnp.arange(nq)))
    return o.transpose(1, 2, 0, 3, 4).reshape(Bsz, H, S, Dh)


def moe_ffn(h, w_router, b_router, w1, b1, w2, b2):
    Bsz, S, D = h.shape
    N = Bsz * S
    t = h.reshape(N, D)
    logits = (t @ w_router + b_router).astype(jnp.float32)
    top_v, top_e = lax.top_k(logits, TOP_K)
    gates = jax.nn.softmax(top_v, axis=-1)
    NK = N * TOP_K
    e_flat = top_e.reshape(NK).astype(jnp.int32)
    g_flat = gates.reshape(NK)
    tok_flat = (jnp.arange(NK, dtype=jnp.int32) // TOP_K)
    order = jnp.argsort(e_flat)
    e_sorted = e_flat[order]
    counts = jnp.bincount(e_flat, length=N_EXPERTS).astype(jnp.int32)
    padded = ((counts + EXPERT_BLOCK - 1) // EXPERT_BLOCK) * EXPERT_BLOCK
    start = jnp.cumsum(counts) - counts
    pstart = jnp.cumsum(padded) - padded
    dest = pstart[e_sorted] + (jnp.arange(NK, dtype=jnp.int32) - start[e_sorted])
    n_blocks = -(-NK // EXPERT_BLOCK) + N_EXPERTS
    R = n_blocks * EXPERT_BLOCK
    row_tok = jnp.full((R,), N, dtype=jnp.int32).at[dest].set(tok_flat[order])
    row_gate = jnp.zeros((R,), jnp.float32).at[dest].set(g_flat[order])
    pend = jnp.cumsum(padded)
    block_e = jnp.minimum(jnp.searchsorted(pend, jnp.arange(n_blocks, dtype=jnp.int32) * EXPERT_BLOCK,
                                           side='right'), N_EXPERTS - 1).astype(jnp.int32)
    t_pad = jnp.concatenate([t, jnp.zeros((1, D), t.dtype)], axis=0)

    def expert_block(args):
        rows, e = args
        xb = t_pad[rows]
        hid = xb @ w1[e] + b1[e]
        glu = jnp.minimum(hid[:, :D_FF], SWIGLU_LIMIT)
        lin = jnp.clip(hid[:, D_FF:], -SWIGLU_LIMIT, SWIGLU_LIMIT)
        act = glu * jax.nn.sigmoid(SWIGLU_ALPHA * glu) * (lin + 1.0)
        return act @ w2[e] + b2[e]

    y_rows = lax.map(expert_block, (row_tok.reshape(n_blocks, EXPERT_BLOCK), block_e))
    y_rows = y_rows.astype(jnp.float32) * row_gate.reshape(n_blocks, EXPERT_BLOCK, 1)
    y = jnp.zeros((N + 1, D), jnp.float32).at[row_tok].add(y_rows.reshape(R, D))[:N]
    return y.reshape(Bsz, S, D).astype(h.dtype)


def setup_inputs(seed: int = 0) -> dict:
    key = jax.random.key(seed)
    ks = jax.random.split(key, 20)
    D, E, F = D_MODEL, N_EXPERTS, D_FF
    nrm = lambda k, shape, fan: jax.random.normal(k, shape, jnp.float32) * (fan ** -0.5)
    return {
        "x": jax.random.normal(ks[0], (BATCH, SEQ, D), jnp.float32),
        "norm1_g": 1.0 + 0.02 * jax.random.normal(ks[1], (DEPTH, D), jnp.float32),
        "w_in": nrm(ks[2], (DEPTH, D, IN_COLS), D),
        "w_proj_a": nrm(ks[3], (DEPTH, WIDTH_A, D), WIDTH_A),
        "w_proj_b": nrm(ks[4], (DEPTH, WIDTH_B, D), WIDTH_B),
        "w_gate": nrm(ks[5], (DEPTH, D, 2 * D), D),
        "b_gate": 0.02 * jax.random.normal(ks[6], (DEPTH, 2 * D), jnp.float32),
        "w_out": nrm(ks[7], (DEPTH, D, D), D),
        "norm2_g": 1.0 + 0.02 * jax.random.normal(ks[8], (DEPTH, D), jnp.float32),
        "w_router": nrm(ks[9], (DEPTH, D, E), D),
        "b_router": 0.01 * jax.random.normal(ks[10], (DEPTH, E), jnp.float32),
        "w1": nrm(ks[11], (DEPTH, E, D, 2 * F), D),
        "b1": 0.02 * jax.random.normal(ks[12], (DEPTH, E, 2 * F), jnp.float32),
        "w2": nrm(ks[13], (DEPTH, E, F, D), F),
        "b2": 0.02 * jax.random.normal(ks[14], (DEPTH, E, D), jnp.float32),
        "norm_f_g": 1.0 + 0.02 * jax.random.normal(ks[15], (D,), jnp.float32),
    }


def reference(x, norm1_g, w_in, w_proj_a, w_proj_b, w_gate, b_gate, w_out, norm2_g,
              w_router, b_router, w1, b1, w2, b2, norm_f_g):
    Bsz, S, D = x.shape
    pos = jnp.arange(S, dtype=jnp.int32)

    def heads(a, n_heads):
        return a.reshape(Bsz, S, n_heads, HEAD_DIM).transpose(0, 2, 1, 3)

    for l in range(DEPTH):
        h = rmsnorm(x, norm1_g[l])
        proj = h @ w_in[l]
        qa, ka, va, qb, kb, vb = jnp.split(
            proj, [WIDTH_A, 2 * WIDTH_A, 3 * WIDTH_A, 3 * WIDTH_A + WIDTH_B,
                   3 * WIDTH_A + 2 * WIDTH_B], axis=-1)
        qa = partial_rotary(heads(qa, N_HEADS_A), pos)
        ka = partial_rotary(heads(ka, N_HEADS_A), pos)
        o_a = dilated_attention(qa, ka, heads(va, N_HEADS_A))
        o_a = o_a.transpose(0, 2, 1, 3).reshape(Bsz, S, WIDTH_A).astype(x.dtype)
        o_b = stick_breaking_attention(heads(qb, N_HEADS_B), heads(kb, N_HEADS_B), heads(vb, N_HEADS_B))
        o_b = o_b.transpose(0, 2, 1, 3).reshape(Bsz, S, WIDTH_B).astype(x.dtype)
        g = jax.nn.sigmoid((h @ w_gate[l] + b_gate[l]).astype(jnp.float32))
        merged = g[..., :D] * (o_a @ w_proj_a[l]) + g[..., D:] * (o_b @ w_proj_b[l])
        x = x + (merged.astype(x.dtype) @ w_out[l])
        h2 = rmsnorm(x, norm2_g[l])
        x = x + moe_ffn(h2, w_router[l], b_router[l], w1[l], b1[l], w2[l], b2[l])
    return rmsnorm(x, norm_f_g)
```

```cpp
#include <hip/hip_runtime.h>
#include <stdint.h>
#include <stdio.h>

#ifndef ABL_A
#define ABL_A 0
#endif
typedef unsigned short bf16_t;
typedef short bf16x8 __attribute__((ext_vector_type(8)));
typedef float f32x4 __attribute__((ext_vector_type(4)));
typedef unsigned u32x2 __attribute__((ext_vector_type(2)));
typedef unsigned u32x4 __attribute__((ext_vector_type(4)));

constexpr int NTOK = 65536, SEQ = 4096, DM = 1024, NE = 32, TOPK = 4;
constexpr int PROJ_NC = 3072, PROJ_LD = 3136, GATE_LD = 2048;
constexpr int NSLOT = NTOK * TOPK;
constexpr int MAXROWS = NSLOT + NE * 256;
constexpr int MAXTILES = MAXROWS / 256;
constexpr int PASS_TILES = 1056;
constexpr int NPASS = 1;

constexpr size_t MiB = 1ull << 20;
constexpr size_t WS_CTRL   = 0;
constexpr size_t WS_BAR    = 64 * 1024;
constexpr size_t WS_ROPE   = 128 * 1024;
constexpr size_t WS_TOKE   = 1 * MiB;
constexpr size_t WS_TOKG   = 2 * MiB;
constexpr size_t WS_STOK   = 3 * MiB;
constexpr size_t WS_RDST   = 5 * MiB;
constexpr size_t WS_RGATE  = 7 * MiB;
constexpr size_t WS_RNORM  = 8 * MiB + 512 * 1024;
constexpr size_t WS_AMAX   = 8 * MiB + 768 * 1024;
constexpr size_t WS_SX     = 14 * MiB;
constexpr size_t WS_SWIN   = 15 * MiB;
constexpr size_t WS_SW1    = 16 * MiB;
constexpr size_t WS_SW2    = 16 * MiB + 256 * 1024;
constexpr size_t WS_RSS    = 17 * MiB;
constexpr size_t WS_WIN    = 9 * MiB;
constexpr size_t WS_PA     = 19 * MiB;
constexpr size_t WS_PB     = 20 * MiB;
constexpr size_t WS_WOUT   = 21 * MiB;
constexpr size_t WS_W1     = 23 * MiB;
constexpr size_t WS_W2     = 151 * MiB;
constexpr size_t WS_R0     = 215 * MiB;
constexpr size_t WS_XN     = WS_R0;
constexpr size_t WS_OAB    = WS_R0;
constexpr size_t WS_PROJ   = WS_R0 + 128 * MiB;
constexpr size_t WS_MERGED = WS_PROJ;
constexpr size_t WS_GATE   = WS_R0 + 520 * MiB;
constexpr size_t WS_H2     = 87 * MiB;
constexpr size_t WS_ACT    = WS_R0;
constexpr size_t WS_Y      = WS_R0 + 264 * MiB;
constexpr size_t WS_X1     = WS_Y + 256 * MiB;
constexpr size_t WS_NEED   = WS_Y + 512 * MiB;

constexpr int C_CNT = 0;
constexpr int C_FILL = 64;
constexpr int C_PSTART = 128;
constexpr int C_NTILES = 192;
constexpr int C_TILEE = 256;

__device__ __forceinline__ bf16_t f2bf(float f) { unsigned u = __float_as_uint(f); u += 0x7FFFu + ((u >> 16) & 1u); return (bf16_t)(u >> 16); }
__device__ __forceinline__ float bf2f(bf16_t b) { return __uint_as_float((unsigned)b << 16); }
__device__ __forceinline__ unsigned pack2(float lo, float hi) { return (unsigned)f2bf(lo) | ((unsigned)f2bf(hi) << 16); }
__device__ __forceinline__ float wave_sum(float v) {
#pragma unroll
    for (int o = 32; o > 0; o >>= 1) v += __shfl_xor(v, o);
    return v; }
__device__ __forceinline__ float wave_max(float v) {
#pragma unroll
    for (int o = 32; o > 0; o >>= 1) v = fmaxf(v, __shfl_xor(v, o));
    return v; }
__device__ __forceinline__ float sigmoidf_(float x) { return __builtin_amdgcn_rcpf(1.0f + __builtin_amdgcn_exp2f(x * -1.4426950408889634f)); }


#define XB_TMO      128
#define XB_XCNT(j)  (256  + 64 * (j))
#define XB_XSUB(j)  (1280 + 64 * (j))
#define XB_XGEN(j)  (2304 + 64 * (j))
#define XB_TOP      3328
#define XB_TOPGEN   3392
#define XCD_BAR_WORDS 3456
#define XB_SPIN_CAP (1u << 22)
#define LAS __attribute__((address_space(3)))
__device__ __forceinline__ unsigned xb_ld(unsigned* p)              { return __hip_atomic_load(p, __ATOMIC_RELAXED, __HIP_MEMORY_SCOPE_AGENT); }
__device__ __forceinline__ unsigned xb_add(unsigned* p, unsigned v) { return __hip_atomic_fetch_add(p, v, __ATOMIC_RELAXED, __HIP_MEMORY_SCOPE_AGENT); }
__device__ __forceinline__ unsigned xb_xcc_id() { return (unsigned)__builtin_amdgcn_s_getreg((3 << 11) | 20) & 0xFu; }
#define XB_SPIN(cond, bar) do { unsigned _sp = 0; while (cond) { __builtin_amdgcn_s_sleep(1); \
    if ((++_sp & 255u) == 0u) { if (xb_ld(&(bar)[XB_TMO])) break; if (_sp > XB_SPIN_CAP) { atomicAdd(&(bar)[XB_TMO], 1u); break; } } } } while (0)
struct XcdBarrier { unsigned* bar; unsigned x; volatile LAS unsigned* st; };
__device__ __forceinline__ XcdBarrier xcd_barrier_post(unsigned* bar, volatile LAS unsigned* st) {
    XcdBarrier b; b.bar = bar; b.x = xb_xcc_id(); b.st = st;
    if (threadIdx.x == 0) (void)xb_add(&bar[XB_XCNT(b.x)], 1u);
    return b;
}
__device__ __forceinline__ void xcd_barrier_complete(unsigned* bar, unsigned x, unsigned& nloc, unsigned& nx) {
    const unsigned G = gridDim.x * gridDim.y * gridDim.z;
    unsigned sum, cnt, mine, sp = 0u;
    for (;;) {
        sum = 0u; cnt = 0u; mine = 0u;
#pragma unroll
        for (unsigned j = 0; j < 16; ++j) { const unsigned c = xb_ld(&bar[XB_XCNT(j)]); sum += c; cnt += (c > 0u) ? 1u : 0u; mine = (j == x) ? c : mine; }
        if (sum == G) break;
        __builtin_amdgcn_s_sleep(1);
        if ((++sp & 255u) == 0u) { if (xb_ld(&bar[XB_TMO])) break; if (sp > XB_SPIN_CAP) { atomicAdd(&bar[XB_TMO], 1u); break; } }
    }
    nloc = mine > 0u ? mine : 1u; nx = cnt > 0u ? cnt : 1u;
}
__device__ __forceinline__ void xcd_barrier(const XcdBarrier& b) {
    asm volatile("s_waitcnt vmcnt(0)" ::: "memory");
    __syncthreads();
    if (threadIdx.x == 0) {
        unsigned* bar = b.bar;
        __builtin_amdgcn_s_waitcnt(0);
        unsigned nloc = b.st[0], nx = b.st[1];
        if (nloc == 0u) { xcd_barrier_complete(bar, b.x, nloc, nx); b.st[0] = nloc; b.st[1] = nx; }
        const unsigned old = xb_add(&bar[XB_XSUB(b.x)], 1u);
        const unsigned gen = old / nloc;
        if (old + 1u == (gen + 1u) * nloc) {
            __builtin_amdgcn_fence(__ATOMIC_RELEASE, "agent");
            asm volatile("s_waitcnt vmcnt(0)" ::: "memory");
            const unsigned og = xb_add(&bar[XB_TOP], 1u);
            const unsigned tg = og / nx;
            if (og + 1u == (tg + 1u) * nx) xb_add(&bar[XB_TOPGEN], 1u);
            else XB_SPIN(xb_ld(&bar[XB_TOPGEN]) == tg, bar);
            __builtin_amdgcn_fence(__ATOMIC_ACQUIRE, "agent");
            xb_add(&bar[XB_XGEN(b.x)], 1u);
            asm volatile("s_waitcnt vmcnt(0)" ::: "memory");
        } else {
            XB_SPIN(xb_ld(&bar[XB_XGEN(b.x)]) == gen, bar);
            __builtin_amdgcn_fence(__ATOMIC_ACQUIRE, "agent");
            asm volatile("s_waitcnt vmcnt(0)" ::: "memory");
        }
    }
    __syncthreads();
}

__device__ __forceinline__ int w1map(int c) { const int half = c >> 10, cc = c & 1023; return (cc >> 7) * 256 + half * 128 + (cc & 127); }
template <int MODE>
__device__ __forceinline__ void b_cvt_t(const int vbx, const int vby, const int vbz, const int tid, float (*tile)[65], const float* __restrict__ src, bf16_t* __restrict__ dst, int K, int N) {
    const size_t boff = (size_t)vbz * K * N; src += boff; dst += boff;
    const int n0 = vbx * 64, k0 = vby * 64, tx = tid & 63, ty = tid >> 6;
    for (int i = ty; i < 64; i += 4) tile[i][tx] = src[(size_t)(k0 + i) * N + n0 + tx];
    __syncthreads();
    for (int i = ty; i < 64; i += 4) { const int n = n0 + i; const int np = (MODE == 1) ? w1map(n) : n; dst[(size_t)np * K + k0 + tx] = f2bf(tile[tx][i]); }
}

struct RopeF { float f[8]; };
__device__ __forceinline__ void b_rope_tab(const int vbx, const int vby, const int vbz, const int tid, float* tab, RopeF fr) {
    const int i = vbx * 256 + tid; if (i >= SEQ * 8) return;
    const int pos = i >> 3, j = i & 7;
    const float fj = j == 0 ? fr.f[0] : j == 1 ? fr.f[1] : j == 2 ? fr.f[2] : j == 3 ? fr.f[3] : j == 4 ? fr.f[4] : j == 5 ? fr.f[5] : j == 6 ? fr.f[6] : fr.f[7];
    const float ang = (float)pos * fj;
    float s, c; sincosf(ang, &s, &c); tab[i] = c; tab[SEQ * 8 + i] = s;
}

__device__ __forceinline__ void b_rmsnorm_bf16(const int vbx, const int vby, const int vbz, const int tid, const float* __restrict__ x, const float* __restrict__ g, bf16_t* __restrict__ out) {
    const int row = vbx * 4 + (tid >> 6), lane = tid & 63;
    const float4* xr = (const float4*)(x + (size_t)row * DM); float4 v[4]; float ss = 0.f;
#pragma unroll
    for (int i = 0; i < 4; ++i) { v[i] = xr[lane + 64 * i]; ss += v[i].x * v[i].x + v[i].y * v[i].y + v[i].z * v[i].z + v[i].w * v[i].w; }
    ss = wave_sum(ss); const float r = rsqrtf(ss * (1.0f / DM) + 1e-5f);
#pragma unroll
    for (int i = 0; i < 4; ++i) { const float4 gg = ((const float4*)g)[lane + 64 * i];
        u32x2 w; w.x = pack2(v[i].x * r * gg.x, v[i].y * r * gg.y); w.y = pack2(v[i].z * r * gg.z, v[i].w * r * gg.w);
        *(u32x2*)(out + (size_t)row * DM + 4 * (lane + 64 * i)) = w; }
}

struct GemmArgs {
    const bf16_t* A; const bf16_t* Bt;
    const int* rowidx;
    const int* tile_e;
    const int* ntiles;
    size_t b_estride; int lda, ldb, K, row_base;
};
template <class Epi, bool DUAL>
__device__ __forceinline__ void b_gemm_ref(const int vbx, const int vby, const int vbz, const int tid, GemmArgs g, Epi epi) {
    const int wid = tid >> 6, lane = tid & 63, wr = wid >> 1, wc = wid & 1, fr = lane & 15, fq = lane >> 4;
    const int m0 = vby * 128 + wr * 64, n0 = vbx * 128 + wc * 64;
    int e = 0;
    if (g.ntiles) { const int tile = (g.row_base + vby * 128) >> 8; if (tile >= *g.ntiles) return; e = g.tile_e[tile]; }
    const bf16_t* Bt = g.Bt + (size_t)e * g.b_estride;
    const bf16_t* ap[4]; const bf16_t* bp[4];
#pragma unroll
    for (int m = 0; m < 4; ++m) { int r = m0 + m * 16 + fr; if (g.rowidx) { r = g.rowidx[g.row_base + r]; if (r < 0) r = 0; } ap[m] = g.A + (size_t)r * g.lda + fq * 8; }
#pragma unroll
    for (int n = 0; n < 4; ++n) { int c = n0 + n * 16 + fr; if (DUAL) c = (c >> 7) * 256 + (c & 127); bp[n] = Bt + (size_t)c * g.ldb + fq * 8; }
    f32x4 acc[4][4], acc2[4][4];
#pragma unroll
    for (int m = 0; m < 4; ++m)
#pragma unroll
        for (int n = 0; n < 4; ++n) { acc[m][n] = (f32x4){0.f, 0.f, 0.f, 0.f}; acc2[m][n] = (f32x4){0.f, 0.f, 0.f, 0.f}; }
    for (int k0 = 0; k0 < g.K; k0 += 32) {
        bf16x8 a[4], b[4], b2[4];
#pragma unroll
        for (int m = 0; m < 4; ++m) a[m] = *(const bf16x8*)(ap[m] + k0);
#pragma unroll
        for (int n = 0; n < 4; ++n) { b[n] = *(const bf16x8*)(bp[n] + k0); if (DUAL) b2[n] = *(const bf16x8*)(bp[n] + (size_t)128 * g.ldb + k0); }
#pragma unroll
        for (int m = 0; m < 4; ++m)
#pragma unroll
            for (int n = 0; n < 4; ++n) { acc[m][n] = __builtin_amdgcn_mfma_f32_16x16x32_bf16(b[n], a[m], acc[m][n], 0, 0, 0);
                if (DUAL) acc2[m][n] = __builtin_amdgcn_mfma_f32_16x16x32_bf16(b2[n], a[m], acc2[m][n], 0, 0, 0); }
    }
#pragma unroll
    for (int m = 0; m < 4; ++m)
#pragma unroll
        for (int n = 0; n < 4; ++n) epi(m0 + m * 16 + fr, n0 + n * 16 + 4 * fq, acc[m][n], acc2[m][n], e);
}

struct EpiInProj {
    bf16_t* proj; bf16_t* gate; const float* bgate;
    __device__ void operator()(int row, int col, f32x4 v, f32x4, int) const {
        if (col < PROJ_NC) { u32x2 w; w.x = pack2(v[0], v[1]); w.y = pack2(v[2], v[3]); *(u32x2*)(proj + (size_t)row * PROJ_LD + col) = w; }
        else { const int c = col - PROJ_NC; const f32x4 b = *(const f32x4*)(bgate + c);
            u32x2 w; w.x = pack2(sigmoidf_(v[0] + b[0]), sigmoidf_(v[1] + b[1])); w.y = pack2(sigmoidf_(v[2] + b[2]), sigmoidf_(v[3] + b[3])); *(u32x2*)(gate + (size_t)row * GATE_LD + c) = w; }
    }
};
struct EpiProjA {
    float* tmp; const bf16_t* gate;
    __device__ void operator()(int row, int col, f32x4 v, f32x4, int) const {
        const u32x2 gw = *(const u32x2*)(gate + (size_t)row * GATE_LD + col);
        f32x4 o; o[0] = v[0] * bf2f(gw.x & 0xffff); o[1] = v[1] * bf2f(gw.x >> 16); o[2] = v[2] * bf2f(gw.y & 0xffff); o[3] = v[3] * bf2f(gw.y >> 16);
        *(f32x4*)(tmp + (size_t)row * DM + col) = o; }
};
struct EpiProjB {
    const float* tmp; const bf16_t* gate; bf16_t* merged;
    __device__ void operator()(int row, int col, f32x4 v, f32x4, int) const {
        const u32x2 gw = *(const u32x2*)(gate + (size_t)row * GATE_LD + DM + col); const f32x4 t = *(const f32x4*)(tmp + (size_t)row * DM + col);
        u32x2 w; w.x = pack2(t[0] + v[0] * bf2f(gw.x & 0xffff), t[1] + v[1] * bf2f(gw.x >> 16)); w.y = pack2(t[2] + v[2] * bf2f(gw.y & 0xffff), t[3] + v[3] * bf2f(gw.y >> 16));
        *(u32x2*)(merged + (size_t)row * DM + col) = w; }
};
struct EpiWout {
    const float* x; float* x1;
    __device__ void operator()(int row, int col, f32x4 v, f32x4, int) const {
        const f32x4 xx = *(const f32x4*)(x + (size_t)row * DM + col); *(f32x4*)(x1 + (size_t)row * DM + col) = xx + v; }
};
struct EpiMoe1 {
    bf16_t* act; const float* b1;
    __device__ void operator()(int row, int col, f32x4 v, f32x4 v2, int e) const {
        const f32x4 bg = *(const f32x4*)(b1 + (size_t)e * 2048 + col), bl = *(const f32x4*)(b1 + (size_t)e * 2048 + 1024 + col); float o[4];
#pragma unroll
        for (int i = 0; i < 4; ++i) { const float glu = fminf(v[i] + bg[i], 7.0f), lin = fminf(fmaxf(v2[i] + bl[i], -7.0f), 7.0f); o[i] = glu * sigmoidf_(1.702f * glu) * (lin + 1.0f); }
        u32x2 w; w.x = pack2(o[0], o[1]); w.y = pack2(o[2], o[3]); *(u32x2*)(act + (size_t)row * DM + col) = w; }
};
struct EpiMoe2 {
    bf16_t* y; const float* b2; const int* rdst; const float* rgate; int row_base; int pad_;
    __device__ void operator()(int row, int col, f32x4 v, f32x4, int e) const {
        const int dst = rdst[row_base + row]; if (dst < 0) return; const float gt = rgate[row_base + row]; const f32x4 b = *(const f32x4*)(b2 + (size_t)e * DM + col);
        u32x2 w; w.x = pack2(gt * (v[0] + b[0]), gt * (v[1] + b[1])); w.y = pack2(gt * (v[2] + b[2]), gt * (v[3] + b[3])); *(u32x2*)(y + (size_t)dst * DM + col) = w; }
};

__device__ __forceinline__ void b_rope(const int vbx, const int vby, const int vbz, const int tid, bf16_t* proj, const float* tab) {
    const int i = vbx * 256 + tid;
    const int j = i & 7, head = (i >> 3) & 7, qk = (i >> 6) & 1, tok = i >> 7; if (tok >= NTOK) return;
    bf16_t* p = proj + (size_t)tok * PROJ_LD + qk * 512 + head * 64; const int pos = tok & (SEQ - 1);
    const float c = tab[pos * 8 + j], s = tab[SEQ * 8 + pos * 8 + j], x1 = bf2f(p[j]), x2 = bf2f(p[j + 8]);
    p[j] = f2bf(x1 * c - x2 * s); p[j + 8] = f2bf(x2 * c + x1 * s);
}

__device__ __forceinline__ void load_row64(const bf16_t* p, float* q) {
#pragma unroll
    for (int c = 0; c < 8; ++c) { const u32x4 w = *(const u32x4*)(p + c * 8);
        q[c * 8 + 0] = bf2f(w.x & 0xffff); q[c * 8 + 1] = bf2f(w.x >> 16); q[c * 8 + 2] = bf2f(w.y & 0xffff); q[c * 8 + 3] = bf2f(w.y >> 16);
        q[c * 8 + 4] = bf2f(w.z & 0xffff); q[c * 8 + 5] = bf2f(w.z >> 16); q[c * 8 + 6] = bf2f(w.w & 0xffff); q[c * 8 + 7] = bf2f(w.w >> 16); }
}
__device__ __forceinline__ float dot_row64(const bf16_t* p, const float* q) {
    float s = 0.f;
#pragma unroll
    for (int c = 0; c < 8; ++c) { const u32x4 w = *(const u32x4*)(p + c * 8);
        s += q[c * 8 + 0] * bf2f(w.x & 0xffff) + q[c * 8 + 1] * bf2f(w.x >> 16) + q[c * 8 + 2] * bf2f(w.y & 0xffff) + q[c * 8 + 3] * bf2f(w.y >> 16)
           + q[c * 8 + 4] * bf2f(w.z & 0xffff) + q[c * 8 + 5] * bf2f(w.z >> 16) + q[c * 8 + 6] * bf2f(w.w & 0xffff) + q[c * 8 + 7] * bf2f(w.w >> 16); }
    return s;
}
__device__ __forceinline__ void b_attn_a_ref(const int vbx, const int vby, const int vbz, const int tid, const bf16_t* __restrict__ proj, bf16_t* __restrict__ oab) {
    const int wv = vbx * 4 + (tid >> 6), lane = tid & 63;
    const int t = wv & (SEQ - 1), h = (wv >> 12) & 7, b = wv >> 15;
    const bf16_t* base = proj + (size_t)b * SEQ * PROJ_LD + h * 64;
    float q[64]; load_row64(base + (size_t)t * PROJ_LD, q);
    float sc[7]; float mx = -INFINITY;
#pragma unroll
    for (int it = 0; it < 7; ++it) { const int i = it * 64 + lane; sc[it] = -INFINITY;
        if (i < 387) { const int gi = i / 129, j = i - gi * 129, dil = gi == 0 ? 1 : (gi == 1 ? 4 : 16), kp = t - j * dil;
            if (kp >= 0) sc[it] = dot_row64(base + 512 + (size_t)kp * PROJ_LD, q) * 0.125f; }
        mx = fmaxf(mx, sc[it]); }
    mx = wave_max(mx); float l = 0.f;
#pragma unroll
    for (int it = 0; it < 7; ++it) { sc[it] = (sc[it] == -INFINITY) ? 0.f : __expf(sc[it] - mx); l += sc[it]; }
    l = wave_sum(l); float o = 0.f;
#pragma unroll
    for (int it = 0; it < 7; ++it)
        for (int ln = 0; ln < 64; ++ln) { const int i = it * 64 + ln; if (i >= 387) break;
            const float p = __shfl(sc[it], ln); const int gi = i / 129, j = i - gi * 129, dil = gi == 0 ? 1 : (gi == 1 ? 4 : 16), kp = t - j * dil;
            if (kp >= 0) o += p * bf2f(base[1024 + (size_t)kp * PROJ_LD + lane]); }
    oab[((size_t)b * SEQ + t) * DM + h * 64 + lane] = f2bf(o / l);
}

__device__ __forceinline__ void b_attn_b_ref(const int vbx, const int vby, const int vbz, const int tid, const bf16_t* __restrict__ proj, bf16_t* __restrict__ oab) {
    const int wv = vbx * 4 + (tid >> 6), lane = tid & 63;
    const int t = wv & (SEQ - 1), h = (wv >> 12) & 7, b = wv >> 15;
    const bf16_t* base = proj + (size_t)b * SEQ * PROJ_LD + 1536 + h * 64;
    float q[64]; load_row64(base + (size_t)t * PROJ_LD, q);
    float carry = 0.f, o = 0.f;
    for (int shi = t - 1; shi >= 0; shi -= 64) {
        const int s = shi - lane; const bool valid = s >= 0; float z = 0.f;
        if (valid) z = dot_row64(base + 512 + (size_t)s * PROJ_LD, q) * 0.125f;
        const float sp = fmaxf(z, 0.f) + log1pf(__expf(-fabsf(z)));
        const float lk = valid ? -sp : 0.f;
        float incl = lk;
#pragma unroll
        for (int o2 = 1; o2 < 64; o2 <<= 1) { const float up = __shfl_up(incl, o2); if (lane >= o2) incl += up; }
        const float a = valid ? __expf(z - sp + carry + (incl - lk)) : 0.f;
        carry += __shfl(incl, 63);
        const int nk = (shi + 1) < 64 ? (shi + 1) : 64;
        for (int i = 0; i < nk; ++i) { const float ai = __shfl(a, i); o += ai * bf2f(base[1024 + (size_t)(shi - i) * PROJ_LD + lane]); }
    }
    oab[((size_t)b * SEQ + t) * DM + 512 + h * 64 + lane] = f2bf(o);
}

__device__ __forceinline__ void b_norm2_router(const int vbx, const int vby, const int vbz, const int tid, const float* __restrict__ x1, const float* __restrict__ g2, const float* __restrict__ wr, const float* __restrict__ br,
                                                      bf16_t* __restrict__ h2, int* __restrict__ toke, float* __restrict__ tokg, int* __restrict__ cnt) {
    const int row = vbx * 4 + (tid >> 6), lane = tid & 63;
    const float4* xr = (const float4*)(x1 + (size_t)row * DM); float4 v[4]; float ss = 0.f;
#pragma unroll
    for (int i = 0; i < 4; ++i) { v[i] = xr[lane + 64 * i]; ss += v[i].x * v[i].x + v[i].y * v[i].y + v[i].z * v[i].z + v[i].w * v[i].w; }
    ss = wave_sum(ss); const float r = rsqrtf(ss * (1.0f / DM) + 1e-5f);
    float lg[NE];
#pragma unroll
    for (int e = 0; e < NE; ++e) lg[e] = 0.f;
#pragma unroll 1
    for (int i = 0; i < 4; ++i) { const float4 xv = xr[lane + 64 * i]; const float4 gg = ((const float4*)g2)[lane + 64 * i]; const int c0 = 4 * (lane + 64 * i);
        const float h0 = xv.x * r * gg.x, h1 = xv.y * r * gg.y, h2v = xv.z * r * gg.z, h3 = xv.w * r * gg.w;
        u32x2 w; w.x = pack2(h0, h1); w.y = pack2(h2v, h3); *(u32x2*)(h2 + (size_t)row * DM + c0) = w;
#pragma unroll
        for (int jj = 0; jj < 4; ++jj) { const float4* wrow = (const float4*)(wr + (size_t)(c0 + jj) * NE); const float hv = jj == 0 ? h0 : (jj == 1 ? h1 : (jj == 2 ? h2v : h3));
#pragma unroll
            for (int e4 = 0; e4 < 8; ++e4) { const float4 ww = wrow[e4]; lg[e4 * 4 + 0] += hv * ww.x; lg[e4 * 4 + 1] += hv * ww.y; lg[e4 * 4 + 2] += hv * ww.z; lg[e4 * 4 + 3] += hv * ww.w; } } }
#pragma unroll
    for (int e = 0; e < NE; ++e) lg[e] = wave_sum(lg[e]) + br[e];
    int te[4]; float tv[4];
#pragma unroll
    for (int k = 0; k < 4; ++k) { float best = -INFINITY; int bi = 0;
#pragma unroll
        for (int e = 0; e < NE; ++e) { if (lg[e] > best) { best = lg[e]; bi = e; } }
        te[k] = bi; tv[k] = best;
#pragma unroll
        for (int e = 0; e < NE; ++e) if (e == bi) lg[e] = -INFINITY; }
    const float e1 = __expf(tv[1] - tv[0]), e2 = __expf(tv[2] - tv[0]), e3 = __expf(tv[3] - tv[0]), inv = 1.0f / (1.0f + e1 + e2 + e3);
    if (lane == 0) { *(int4*)(toke + (size_t)row * 4) = make_int4(te[0], te[1], te[2], te[3]); *(float4*)(tokg + (size_t)row * 4) = make_float4(inv, e1 * inv, e2 * inv, e3 * inv);
        atomicAdd(cnt + te[0], 1); atomicAdd(cnt + te[1], 1); atomicAdd(cnt + te[2], 1); atomicAdd(cnt + te[3], 1); }
}
__device__ __forceinline__ void b_scan(const int vbx, const int vby, const int vbz, const int tid, int* ctrl) {
    if (tid != 0 || vbx != 0) return;
    int ps = 0, tile = 0;
    for (int e = 0; e < NE; ++e) { ctrl[C_PSTART + e] = ps; const int nt = (ctrl[C_CNT + e] + 255) >> 8; for (int i = 0; i < nt; ++i) ctrl[C_TILEE + tile++] = e; ps += nt * 256; }
    ctrl[C_PSTART + NE] = ps; ctrl[C_NTILES] = tile;
}
__device__ __forceinline__ void b_assign(const int vbx, const int vby, const int vbz, const int tid, const int* __restrict__ toke, const float* __restrict__ tokg, int* ctrl, int* stok, int* rdst, float* rgate) {
    const int i = vbx * 256 + tid; if (i >= NSLOT) return;
    const int e = toke[i]; const int pos = atomicAdd(ctrl + C_FILL + e, 1); const int row = ctrl[C_PSTART + e] + pos;
    stok[row] = i >> 2; rdst[row] = i; rgate[row] = tokg[i];
}
__device__ __forceinline__ void b_final(const int vbx, const int vby, const int vbz, const int tid, float* __restrict__ xo, const bf16_t* __restrict__ y, const float* __restrict__ gf) {
    const int row = vbx * 4 + (tid >> 6), lane = tid & 63;
    float4* xr = (float4*)(xo + (size_t)row * DM); float4 v[4]; float ss = 0.f;
#pragma unroll
    for (int i = 0; i < 4; ++i) { v[i] = xr[lane + 64 * i];
#pragma unroll
        for (int k = 0; k < 4; ++k) { const u32x2 w = *(const u32x2*)(y + ((size_t)row * 4 + k) * DM + 4 * (lane + 64 * i));
            v[i].x += bf2f(w.x & 0xffff); v[i].y += bf2f(w.x >> 16); v[i].z += bf2f(w.y & 0xffff); v[i].w += bf2f(w.y >> 16); }
        ss += v[i].x * v[i].x + v[i].y * v[i].y + v[i].z * v[i].z + v[i].w * v[i].w; }
    ss = wave_sum(ss); const float r = rsqrtf(ss * (1.0f / DM) + 1e-5f);
#pragma unroll
    for (int i = 0; i < 4; ++i) { const float4 gg = ((const float4*)gf)[lane + 64 * i]; xr[lane + 64 * i] = make_float4(v[i].x * r * gg.x, v[i].y * r * gg.y, v[i].z * r * gg.z, v[i].w * r * gg.w); }
}


extern __shared__ __attribute__((aligned(16))) unsigned char dyn_lds[];

typedef float f32x16 __attribute__((ext_vector_type(16)));
typedef short s16x4 __attribute__((ext_vector_type(4)));
typedef short v4i16_t __attribute__((ext_vector_type(4)));
#define MFMA32(a, b, c) __builtin_amdgcn_mfma_f32_32x32x16_bf16(a, b, c, 0, 0, 0)
__device__ __forceinline__ int crow(int r, int hi) { return (r & 3) + 8 * (r >> 2) + 4 * hi; }
typedef __bf16 bf16x2_t __attribute__((ext_vector_type(2)));
typedef float f32x2_t __attribute__((ext_vector_type(2)));
__device__ __forceinline__ unsigned cvtpk(float lo, float hi) { const f32x2_t v = {lo, hi}; const bf16x2_t b = __builtin_convertvector(v, bf16x2_t); return __builtin_bit_cast(unsigned, b); }
__device__ __forceinline__ unsigned pack4_i8(const f32x4& v, float sc) {
    const unsigned q0 = __float_as_uint(__builtin_fmaf(v[0], sc, 12582912.0f)), q1 = __float_as_uint(__builtin_fmaf(v[1], sc, 12582912.0f)), q2 = __float_as_uint(__builtin_fmaf(v[2], sc, 12582912.0f)), q3 = __float_as_uint(__builtin_fmaf(v[3], sc, 12582912.0f));
    return __builtin_amdgcn_perm(__builtin_amdgcn_perm(q3, q2, 0x0c0c0400u), __builtin_amdgcn_perm(q1, q0, 0x0c0c0400u), 0x05040100u);
}
__device__ __forceinline__ s16x4 vtr(const LAS char* p) { return __builtin_bit_cast(s16x4, __builtin_amdgcn_ds_read_tr16_b64_v4i16((LAS v4i16_t*)p)); }
#define WAVE_FENCE() asm volatile("" ::: "memory")
constexpr float C2LOG = 0.125f * 1.4426950408889634f;
constexpr int MIX_WAVE_LDS = 8448;
constexpr int MIX_LDS_BASE = 1024;
constexpr int MIX_STG = 4096, MIX_ASC = 8192;
constexpr int MIX_PARK = MIX_LDS_BASE + 8 * MIX_WAVE_LDS;
constexpr int MIX_PLSE = MIX_PARK + 512 * 128;

__device__ __forceinline__ void mix_load_k(bf16x8 (&kf)[4], const bf16_t* kbase, int lfirst, int dil, int rr, int r32, int hi) {
    int l = lfirst + r32; l = l < 0 ? 0 : l;
    const char* base = (const char*)(kbase + (size_t)rr * PROJ_LD); const unsigned off = (unsigned)(l * dil) * (unsigned)(PROJ_LD * 2) + (unsigned)hi * 16u;
#pragma unroll
    for (int d0 = 0; d0 < 4; ++d0) kf[d0] = *(const bf16x8*)(base + off + d0 * 32);
}
__device__ __forceinline__ void mix_load_v(u32x4 (&vr)[4], const bf16_t* vbase, int lfirst, int dil, int rr, int lane) {
    const char* base = (const char*)(vbase + (size_t)rr * PROJ_LD);
#pragma unroll
    for (int c = 0; c < 2; ++c) { int l = lfirst + c * 16 + (lane >> 2); l = l < 0 ? 0 : l;
        const unsigned off = (unsigned)(l * dil) * (unsigned)(PROJ_LD * 2) + (unsigned)(lane & 3) * 16u;
        vr[c] = *(const u32x4*)(base + off); vr[c + 2] = *(const u32x4*)(base + off + 64); }
}
__device__ __forceinline__ void mix_store_v(const u32x4 (&vr)[4], LAS char* slot, int lane) {
    WAVE_FENCE();
#pragma unroll
    for (int c = 0; c < 4; ++c) *(LAS u32x4*)(slot + c * 1024 + lane * 16) = vr[c];
    WAVE_FENCE();
}
__device__ __forceinline__ void mix_pv(f32x16& o0, f32x16& o1, const u32x4& pw0, const u32x4& pw1, const LAS char* slot, int lane) {
    const int hi = lane >> 5; const LAS char* vb = slot + (4 * hi + ((lane & 15) >> 2)) * 64 + ((lane >> 4) & 1) * 32 + (lane & 3) * 8;
#pragma unroll
    for (int dh = 0; dh < 2; ++dh)
#pragma unroll
        for (int ks = 0; ks < 2; ++ks) { const s16x4 lo = vtr(vb + dh * 2048 + ks * 1024), hh = vtr(vb + dh * 2048 + ks * 1024 + 512);
            const bf16x8 vf = (bf16x8){lo[0], lo[1], lo[2], lo[3], hh[0], hh[1], hh[2], hh[3]};
            const bf16x8 pf = __builtin_bit_cast(bf16x8, ks == 0 ? pw0 : pw1);
            if (dh == 0) o0 = MFMA32(pf, vf, o0); else o1 = MFMA32(pf, vf, o1); }
}
__device__ __forceinline__ void mix_stage_o(const f32x16& o0, const f32x16& o1, LAS char* stg, int r32, int hi) {
    WAVE_FENCE();
#pragma unroll
    for (int r = 0; r < 16; ++r) { const int q = crow(r, hi);
        *(LAS bf16_t*)(stg + (q * 64 + r32) * 2) = f2bf(o0[r]); *(LAS bf16_t*)(stg + (q * 64 + 32 + r32) * 2) = f2bf(o1[r]); }
    WAVE_FENCE();
}

__device__ __forceinline__ void mixb_first(const bf16_t* __restrict__ proj, int b, int h, int jt, int lane, bf16x8 (&qr)[4], bf16x8 (&kf)[4], u32x4 (&vr)[4]) {
    const int r32 = lane & 31, hi = lane >> 5, t0 = jt * 32;
    const bf16_t* qb = proj + (size_t)b * SEQ * PROJ_LD + 1536 + h * 64;
#pragma unroll
    for (int d0 = 0; d0 < 4; ++d0) qr[d0] = *(const bf16x8*)(qb + (size_t)(t0 + r32) * PROJ_LD + d0 * 16 + hi * 8);
    mix_load_k(kf, qb + 512, t0, 1, 0, r32, hi); mix_load_v(vr, qb + 1024, t0, 1, 0, lane);
}
__device__ __forceinline__ void mixb_tile(const bf16_t* __restrict__ proj, bf16_t* __restrict__ oab, int b, int h, int jt, LAS char* wl, int lane, const bf16x8 (&qr)[4], bf16x8 (&kf)[4], u32x4 (&vr)[4]) {
    const int r32 = lane & 31, hi = lane >> 5, t0 = jt * 32;
    const bf16_t* qb = proj + (size_t)b * SEQ * PROJ_LD + 1536 + h * 64;
    f32x16 o0, o1;
#pragma unroll
    for (int r = 0; r < 16; ++r) { o0[r] = 0.f; o1[r] = 0.f; }
    float carry = 0.f;
    for (int kt = jt; kt >= 0; --kt) {
        LAS char* slot = wl + (kt & 1) * 4096;
        mix_store_v(vr, slot, lane);
        bf16x8 kn[4]; const int snext = (kt > 0 ? kt - 1 : 0) * 32;
        mix_load_k(kn, qb + 512, snext, 1, 0, r32, hi); mix_load_v(vr, qb + 1024, snext, 1, 0, lane);
        __builtin_amdgcn_sched_barrier(0);
        f32x16 z;
#pragma unroll
        for (int r = 0; r < 16; ++r) z[r] = 0.f;
#pragma unroll
        for (int d0 = 0; d0 < 4; ++d0) z = MFMA32(kf[d0], qr[d0], z);
        const bool diag = (kt == jt);
        float lk[16], ls[16];
#pragma unroll
        for (int r = 0; r < 16; ++r) { const float z2 = z[r]; const float e = __builtin_amdgcn_exp2f(-__builtin_fabsf(z2));
            const float sp = __builtin_fmaxf(z2, 0.f) + __builtin_amdgcn_logf(1.0f + e);
            const bool ok = !diag || (crow(r, hi) < r32);
            lk[r] = ok ? -sp : 0.f; ls[r] = ok ? (z2 - sp) : -INFINITY; }
        float G[4], PG[4], T[4];
#pragma unroll
        for (int c = 0; c < 4; ++c) { G[c] = (lk[4 * c] + lk[4 * c + 1]) + (lk[4 * c + 2] + lk[4 * c + 3]); PG[c] = __shfl_xor(G[c], 32); T[c] = G[c] + PG[c]; }
        const float ST2 = T[3], ST1 = T[3] + T[2], ST0 = ST1 + T[1];
        const float STc[4] = {ST0, ST1, ST2, 0.f};
        float a[16];
#pragma unroll
        for (int c = 0; c < 4; ++c) { float af = carry + STc[c] + (hi == 0 ? PG[c] : 0.f);
            a[4 * c + 3] = __builtin_amdgcn_exp2f(ls[4 * c + 3] + af); af += lk[4 * c + 3];
            a[4 * c + 2] = __builtin_amdgcn_exp2f(ls[4 * c + 2] + af); af += lk[4 * c + 2];
            a[4 * c + 1] = __builtin_amdgcn_exp2f(ls[4 * c + 1] + af); af += lk[4 * c + 1];
            a[4 * c + 0] = __builtin_amdgcn_exp2f(ls[4 * c + 0] + af); }
        carry += ST0 + T[0];
        u32x4 pw0, pw1;
        pw0.x = cvtpk(a[0], a[1]); pw0.y = cvtpk(a[2], a[3]); pw0.z = cvtpk(a[4], a[5]); pw0.w = cvtpk(a[6], a[7]);
        pw1.x = cvtpk(a[8], a[9]); pw1.y = cvtpk(a[10], a[11]); pw1.z = cvtpk(a[12], a[13]); pw1.w = cvtpk(a[14], a[15]);
        mix_pv(o0, o1, pw0, pw1, slot, lane);
        if (__all(carry < -126.0f)) break;
#pragma unroll
        for (int d0 = 0; d0 < 4; ++d0) kf[d0] = kn[d0];
    }
    LAS char* stg = wl + MIX_STG;
    mix_stage_o(o0, o1, stg, r32, hi);
    bf16_t* Ow = oab + ((size_t)b * SEQ + t0) * DM + 512 + h * 64;
#pragma unroll
    for (int i = 0; i < 4; ++i) { const int row = i * 8 + (lane >> 3), ch = lane & 7; *(u32x4*)(Ow + (size_t)row * DM + ch * 8) = *(const LAS u32x4*)(stg + row * 128 + ch * 16); }
}
__device__ __forceinline__ void phase_mix_b(const bf16_t* proj, bf16_t* oab) {
    int tidx = threadIdx.x; asm volatile("" : "+v"(tidx));
    const int wid = __builtin_amdgcn_readfirstlane(tidx >> 6), lane = tidx & 63;
    LAS char* wl = (LAS char*)dyn_lds + MIX_LDS_BASE + wid * MIX_WAVE_LDS;
    const int Gm = (int)gridDim.x, vcu = (Gm % 8 == 0) ? ((int)blockIdx.x % 8) * (Gm / 8) + (int)blockIdx.x / 8 : (int)blockIdx.x;
    const int u0 = vcu * 8 + wid, ustep = Gm * 8;
    bf16x8 qA[4], kA[4], qB[4], kB[4]; u32x4 vA[4], vB[4];
    if (u0 < 8192) mixb_first(proj, u0 >> 9, (u0 >> 6) & 7, u0 & 63, lane, qA, kA, vA);
    for (int u = u0; u < 8192; u += ustep) {
        const int bh = u >> 6, pj = u & 63, b = bh >> 3, h = bh & 7;
        mixb_first(proj, b, h, 127 - pj, lane, qB, kB, vB);
        __builtin_amdgcn_sched_barrier(0);
        mixb_tile(proj, oab, b, h, pj, wl, lane, qA, kA, vA);
        const int un = u + ustep;
        if (un < 8192) mixb_first(proj, un >> 9, (un >> 6) & 7, un & 63, lane, qA, kA, vA);
        __builtin_amdgcn_sched_barrier(0);
        mixb_tile(proj, oab, b, h, 127 - pj, wl, lane, qB, kB, vB);
    }
}

__device__ __forceinline__ void mixa_tile(const bf16_t* __restrict__ qa, int l0, int dil, int rr, LAS char* wl, int lane, f32x16& o0, f32x16& o1, float& lse2, int abl) {
    const int r32 = lane & 31, hi = lane >> 5;
    bf16x8 qr[4];
#pragma unroll
    for (int d0 = 0; d0 < 4; ++d0) qr[d0] = *(const bf16x8*)(qa + (size_t)((l0 + r32) * dil + rr) * PROJ_LD + d0 * 16 + hi * 8);
    const int jlo = max(r32, 128 - l0), jhi = r32 + 128;
    bf16x8 ka[4], kb[4]; u32x4 va[4];
    mix_load_k(ka, qa + 512, l0 - 128, dil, rr, r32, hi); mix_load_k(kb, qa + 512, l0 - 96, dil, rr, r32, hi); mix_load_v(va, qa + 1024, l0 - 128, dil, rr, lane);
    __builtin_amdgcn_sched_barrier(0);
    float m2 = -INFINITY, l = 0.f;
#pragma unroll
    for (int r = 0; r < 16; ++r) { o0[r] = 0.f; o1[r] = 0.f; }
    LAS float* asc = (LAS float*)(wl + MIX_ASC);
#pragma unroll 1
    for (int kt = 0; kt < ((abl & 4) ? 0 : 5); ++kt) {
        LAS char* slot = wl + (kt & 1) * 4096;
        mix_store_v(va, slot, lane);
        mix_load_v(va, qa + 1024, l0 - 128 + 32 * (kt + 1 < 5 ? kt + 1 : 4), dil, rr, lane);
        bf16x8 kc[4];
#pragma unroll
        for (int d0 = 0; d0 < 4; ++d0) { kc[d0] = ka[d0]; ka[d0] = kb[d0]; }
        mix_load_k(kb, qa + 512, l0 - 128 + 32 * (kt + 2 < 5 ? kt + 2 : 4), dil, rr, r32, hi);
        __builtin_amdgcn_sched_barrier(0);
        const bool first = (m2 == -INFINITY); const float zi = first ? 0.f : -m2;
        f32x16 z;
#pragma unroll
        for (int r = 0; r < 16; ++r) z[r] = zi;
#pragma unroll
        for (int d0 = 0; d0 < 4; ++d0) z = MFMA32(kc[d0], qr[d0], z);
        float tm = -INFINITY;
        if (!(kt >= 1 && kt <= 3 && 32 * kt >= 128 - l0)) {
#pragma unroll
            for (int r = 0; r < 16; ++r) { const int jk = 32 * kt + crow(r, hi); if (!(jk >= jlo && jk <= jhi)) z[r] = -INFINITY; } }
#pragma unroll
        for (int r = 0; r < 16; ++r) tm = __builtin_fmaxf(tm, z[r]);
        tm = __builtin_fmaxf(tm, __shfl_xor(tm, 32));
        const float d = first ? (tm == -INFINITY ? 0.f : tm) : (tm > 8.0f ? tm : 0.f);
        m2 = first ? tm : m2 + d;
        float ps = 0.f; float pr[16];
        const float alpha = first ? 0.f : __builtin_amdgcn_exp2f(-d);
#pragma unroll
        for (int r = 0; r < 16; ++r) { const float pv = __builtin_amdgcn_exp2f(z[r] - d); pr[r] = pv; ps += pv; }
        l = l * alpha + ps;
        if (__any(d != 0.f)) {
            WAVE_FENCE(); if (hi == 0) asc[r32] = alpha; WAVE_FENCE();
#pragma unroll
            for (int c = 0; c < 4; ++c) { const f32x4 a4 = *(const LAS f32x4*)(asc + 8 * c + 4 * hi);
#pragma unroll
                for (int j = 0; j < 4; ++j) { o0[4 * c + j] *= a4[j]; o1[4 * c + j] *= a4[j]; } } }
        u32x4 pw0, pw1;
        pw0.x = cvtpk(pr[0], pr[1]); pw0.y = cvtpk(pr[2], pr[3]); pw0.z = cvtpk(pr[4], pr[5]); pw0.w = cvtpk(pr[6], pr[7]);
        pw1.x = cvtpk(pr[8], pr[9]); pw1.y = cvtpk(pr[10], pr[11]); pw1.z = cvtpk(pr[12], pr[13]); pw1.w = cvtpk(pr[14], pr[15]);
        mix_pv(o0, o1, pw0, pw1, slot, lane); }
    l += __shfl_xor(l, 32);
    lse2 = m2 + __builtin_amdgcn_logf(l);
    const float rl = 1.0f / l;
#pragma unroll
    for (int r = 0; r < 16; ++r) { const float rq = __shfl(rl, crow(r, hi)); o0[r] *= rq; o1[r] *= rq; }
}
__device__ __forceinline__ void mixa_step(const bf16x8 (&kc)[4], const bf16x8 (&qr)[4], int jk0, int jlo, int jhi, const LAS char* slot, LAS float* asc, int lane, float& m2, float& l, f32x16& o0, f32x16& o1, int jlo_u) {
    const int r32 = lane & 31, hi = lane >> 5;
    const bool first = (m2 == -INFINITY); const float zi = first ? 0.f : -m2;
    f32x16 z;
#pragma unroll
    for (int r = 0; r < 16; ++r) z[r] = zi;
#pragma unroll
    for (int d0 = 0; d0 < 4; ++d0) z = MFMA32(kc[d0], qr[d0], z);
    float tm = -INFINITY;
    if (jk0 >= 32 && jk0 <= 96 && jk0 >= jlo_u) {
#pragma unroll
        for (int r = 0; r < 16; ++r) tm = __builtin_fmaxf(tm, z[r]);
    } else {
#pragma unroll
        for (int r = 0; r < 16; ++r) { const int jk = jk0 + crow(r, hi); const float v = (jk >= jlo && jk <= jhi) ? z[r] : -INFINITY; z[r] = v; tm = __builtin_fmaxf(tm, v); }
    }
    tm = __builtin_fmaxf(tm, __shfl_xor(tm, 32));
    const float d = first ? (tm == -INFINITY ? 0.f : tm) : (tm > 8.0f ? tm : 0.f);
    m2 = first ? tm : m2 + d;
    float ps = 0.f;
    const float alpha = first ? 0.f : __builtin_amdgcn_exp2f(-d);
#pragma unroll
    for (int r = 0; r < 16; ++r) { const float pv = __builtin_amdgcn_exp2f(z[r] - d); z[r] = pv; ps += pv; }
    l = l * alpha + ps;
    if (__any(d != 0.f)) {
        WAVE_FENCE(); if (hi == 0) asc[r32] = alpha; WAVE_FENCE();
#pragma unroll
        for (int c = 0; c < 4; ++c) { const f32x4 a4 = *(const LAS f32x4*)(asc + 8 * c + 4 * hi);
#pragma unroll
            for (int j = 0; j < 4; ++j) { o0[4 * c + j] *= a4[j]; o1[4 * c + j] *= a4[j]; } } }
    u32x4 pw0, pw1;
    pw0.x = cvtpk(z[0], z[1]); pw0.y = cvtpk(z[2], z[3]); pw0.z = cvtpk(z[4], z[5]); pw0.w = cvtpk(z[6], z[7]);
    pw1.x = cvtpk(z[8], z[9]); pw1.y = cvtpk(z[10], z[11]); pw1.z = cvtpk(z[12], z[13]); pw1.w = cvtpk(z[14], z[15]);
    mix_pv(o0, o1, pw0, pw1, slot, lane);
}
__device__ __forceinline__ void mixa_finish(float m2, float l, f32x16& o0, f32x16& o1, float& lse2, int lane) {
    const int hi = lane >> 5;
    l += __shfl_xor(l, 32);
    lse2 = m2 + __builtin_amdgcn_logf(l);
    const float rl = 1.0f / l;
#pragma unroll
    for (int r = 0; r < 16; ++r) { const float rq = __shfl(rl, crow(r, hi)); o0[r] *= rq; o1[r] *= rq; }
}
__device__ __forceinline__ void mixa_tile2(const bf16_t* __restrict__ qa, int l0, int dil, int rr, LAS char* wl, int lane,
                                           f32x16& a0, f32x16& a1, float& lseA, f32x16& b0, f32x16& b1, float& lseB) {
    const int r32 = lane & 31, hi = lane >> 5;
    bf16x8 qA[4], qB[4];
#pragma unroll
    for (int d0 = 0; d0 < 4; ++d0) { qA[d0] = *(const bf16x8*)(qa + (size_t)((l0 + r32) * dil + rr) * PROJ_LD + d0 * 16 + hi * 8); qB[d0] = *(const bf16x8*)(qa + (size_t)((l0 + 32 + r32) * dil + rr) * PROJ_LD + d0 * 16 + hi * 8); }
    const int jloA = max(r32, 128 - l0), jloB = max(r32, 128 - (l0 + 32)), jhi = r32 + 128;
    bf16x8 ka[4]; u32x4 va[4];
    mix_load_k(ka, qa + 512, l0 - 128, dil, rr, r32, hi); mix_load_v(va, qa + 1024, l0 - 128, dil, rr, lane);
    __builtin_amdgcn_sched_barrier(0);
    float mA = -INFINITY, lA = 0.f, mB = -INFINITY, lB = 0.f;
#pragma unroll
    for (int r = 0; r < 16; ++r) { a0[r] = 0.f; a1[r] = 0.f; b0[r] = 0.f; b1[r] = 0.f; }
    LAS float* asc = (LAS float*)(wl + MIX_ASC);
#pragma unroll 1
    for (int kt = 0; kt < 6; ++kt) {
        LAS char* slot = wl + (kt & 1) * 4096;
        mix_store_v(va, slot, lane);
        mix_load_v(va, qa + 1024, l0 - 128 + 32 * (kt + 1 < 6 ? kt + 1 : 5), dil, rr, lane);
        bf16x8 kc[4];
#pragma unroll
        for (int d0 = 0; d0 < 4; ++d0) kc[d0] = ka[d0];
        mix_load_k(ka, qa + 512, l0 - 128 + 32 * (kt + 1 < 6 ? kt + 1 : 5), dil, rr, r32, hi);
        __builtin_amdgcn_sched_barrier(0);
        if (kt < 5) mixa_step(kc, qA, 32 * kt, jloA, jhi, slot, asc, lane, mA, lA, a0, a1, 128 - l0);
        if (kt > 0) mixa_step(kc, qB, 32 * (kt - 1), jloB, jhi, slot, asc, lane, mB, lB, b0, b1, 128 - (l0 + 32));
    }
    mixa_finish(mA, lA, a0, a1, lseA, lane); mixa_finish(mB, lB, b0, b1, lseB, lane);
}
__device__ __forceinline__ void mixa_epi_merge2(const f32x16& o0, const f32x16& o1, float lse1, LAS char* wl, LAS char* stg, LAS char* park, LAS float* plse, int lfirst  , int dil, int lane) {
    const int r32 = lane & 31, hi = lane >> 5;
    mix_stage_o(o0, o1, stg, r32, hi);
    WAVE_FENCE(); if (hi == 0) *(LAS float*)(wl + r32 * 4) = lse1; WAVE_FENCE();
#pragma unroll
    for (int i = 0; i < 4; ++i) { const int row = i * 8 + (lane >> 3), ch = lane & 7; const int loc = lfirst + row * dil;
        const float e1 = *(const LAS float*)(wl + row * 4), e0 = plse[loc];
        const float M = __builtin_fmaxf(e0, e1);
        float w0 = __builtin_amdgcn_exp2f(e0 - M), w1 = __builtin_amdgcn_exp2f(e1 - M); const float sm = w0 + w1, inv = __builtin_amdgcn_rcpf(sm); w0 *= inv; w1 *= inv;
        const u32x4 c1 = *(const LAS u32x4*)(stg + row * 128 + ch * 16), c0 = *(const LAS u32x4*)(park + loc * 128 + ch * 16);
        u32x4 out;
#pragma unroll
        for (int k = 0; k < 4; ++k) { const float lo = w0 * bf2f(c0[k] & 0xffff) + w1 * bf2f(c1[k] & 0xffff), hh = w0 * bf2f(c0[k] >> 16) + w1 * bf2f(c1[k] >> 16); out[k] = cvtpk(lo, hh); }
        WAVE_FENCE();
        *(LAS u32x4*)(park + loc * 128 + ch * 16) = out; if (ch == 0) plse[loc] = M + __builtin_amdgcn_logf(sm);
        WAVE_FENCE(); }
}
__device__ __forceinline__ void mixa_epi_merge(const f32x16& o0, const f32x16& o1, float lse2, LAS char* wl, LAS char* stg, const LAS char* park, const LAS float* plse, bf16_t* oab, int bh, int B0, int l0, int dil, int rr, int lane) {
    const int r32 = lane & 31, hi = lane >> 5;
    mix_stage_o(o0, o1, stg, r32, hi);
    WAVE_FENCE(); if (hi == 0) *(LAS float*)(wl + r32 * 4) = lse2; WAVE_FENCE();
    const size_t rowb = (size_t)(bh >> 3) * SEQ; const int hc = (bh & 7) * 64;
#pragma unroll
    for (int i = 0; i < 4; ++i) { const int row = i * 8 + (lane >> 3), ch = lane & 7; const int pos = (l0 + row) * dil + rr, loc = pos - B0;
        const float e2 = *(const LAS float*)(wl + row * 4), e0 = plse[loc];
        const float M = __builtin_fmaxf(e2, e0);
        float w0 = __builtin_amdgcn_exp2f(e0 - M), w2 = __builtin_amdgcn_exp2f(e2 - M); const float inv = __builtin_amdgcn_rcpf(w0 + w2); w0 *= inv; w2 *= inv;
        const u32x4 c2 = *(const LAS u32x4*)(stg + row * 128 + ch * 16), c0 = *(const LAS u32x4*)(park + loc * 128 + ch * 16);
        u32x4 out;
#pragma unroll
        for (int k = 0; k < 4; ++k) { const float lo = w0 * bf2f(c0[k] & 0xffff) + w2 * bf2f(c2[k] & 0xffff), hh = w0 * bf2f(c0[k] >> 16) + w2 * bf2f(c2[k] >> 16); out[k] = cvtpk(lo, hh); }
        *(u32x4*)(oab + (rowb + pos) * DM + hc + ch * 8) = out; }
}
__device__ __forceinline__ void phase_mix_a(const bf16_t* proj, bf16_t* oab, int abl) {
    int tidx = threadIdx.x; asm volatile("" : "+v"(tidx));
    const int wid = __builtin_amdgcn_readfirstlane(tidx >> 6), lane = tidx & 63, r32 = lane & 31, hi = lane >> 5;
    LAS char* wl = (LAS char*)dyn_lds + MIX_LDS_BASE + wid * MIX_WAVE_LDS; LAS char* stg = wl + MIX_STG;
    LAS char* park = (LAS char*)dyn_lds + MIX_PARK; LAS float* plse = (LAS float*)((LAS char*)dyn_lds + MIX_PLSE);
    const int Gm = (int)gridDim.x, vcu = (Gm % 8 == 0) ? ((int)blockIdx.x % 8) * (Gm / 8) + (int)blockIdx.x / 8 : (int)blockIdx.x;
    for (int u = vcu; u < 1024; u += Gm) {
        const int bh = u >> 3, blk = u & 7, b = bh >> 3, h = bh & 7, B0 = blk * 512;
        const bf16_t* qa = proj + (size_t)b * SEQ * PROJ_LD + h * 64;
        {
            const int l0 = B0 + 64 * wid; f32x16 a0, a1, b0, b1; float lsA, lsB;
            mixa_tile2(qa, l0, 1, 0, wl, lane, a0, a1, lsA, b0, b1, lsB);
            mix_stage_o(a0, a1, park + (l0 - B0) * 128, r32, hi); mix_stage_o(b0, b1, park + (l0 + 32 - B0) * 128, r32, hi);
            if (hi == 0) { plse[l0 - B0 + r32] = lsA; plse[l0 + 32 - B0 + r32] = lsB; } }
        {
            const int T1 = B0 + 256 * (wid >> 2) + (wid & 3), l0 = T1 / 4, rr = T1 % 4; f32x16 a0, a1, b0, b1; float lsA, lsB;
            mixa_tile2(qa, l0, 4, rr, wl, lane, a0, a1, lsA, b0, b1, lsB);
            __syncthreads();
            mixa_epi_merge2(a0, a1, lsA, wl, stg, park, plse, l0 * 4 + rr - B0, 4, lane);
            mixa_epi_merge2(b0, b1, lsB, wl, stg, park, plse, (l0 + 32) * 4 + rr - B0, 4, lane); }
        __syncthreads();
#pragma unroll 1
        for (int rep = 0; rep < 2; ++rep) {
            const int rr = 2 * wid + rep, l0 = B0 / 16;
            f32x16 o0, o1; float lse2;
            mixa_tile(qa, l0, 16, rr, wl, lane, o0, o1, lse2, abl);
            mixa_epi_merge(o0, o1, lse2, wl, stg, park, plse, oab, bh, B0, l0, 16, rr, lane);
        }
        __syncthreads();
    }
}

namespace pg8 {
#define PG8_LAS __attribute__((address_space(3)))
constexpr int BM = 256, BK = 64, HALF = 128, HTB = HALF * BK * 2, STAGE_BYTES = 8 * HTB, NXCD = 8, WGM = 8;
__device__ __forceinline__ int lds_byte(int r, int c) { const int st = (r >> 4) * 2 + (c >> 5), rr = r & 15, cc = c & 31, ob = rr * 64 + cc * 2; return st * 1024 + (ob ^ (((ob >> 9) & 1) << 5)); }
__device__ __forceinline__ void stage_rc(int b, int& R, int& C) { const int st = b / 1024, sb = b % 1024, swz = sb ^ (((sb >> 9) & 1) << 5); R = (st >> 1) * 16 + swz / 64; C = (st & 1) * 32 + (swz % 64) / 2; }
__device__ __forceinline__ int perm32(int rho) { const int n = rho >> 4, i = rho & 15; return 8 * (i >> 2) + 4 * n + (i & 3); }
__device__ __forceinline__ void dma1k_(const void* g  , PG8_LAS unsigned char* dst) { __builtin_amdgcn_global_load_lds((const unsigned*)g, (PG8_LAS unsigned*)dst, 16, 0, 0); }
struct Unit { int pm, pn, e; };
struct Gemm { const void* A; const void* Bt; const int* rowidx; int lda_b, kb, b_erows; };
struct StaticOrder {
    int nM, nN, nwg, G, c;
    __device__ void init(int M, int N, int G_, int c_) { nM = M / BM; nN = N / BM; nwg = nM * nN; G = G_; c = c_; }
    __device__ bool next(int i, Unit& u) const {
        const long L = (long)i * G + c; if (L >= nwg) return false;
        int wgid = (int)L; { const int q = nwg / NXCD, r = nwg % NXCD, xcd = wgid % NXCD, off = wgid / NXCD; wgid = (xcd < r ? xcd * (q + 1) : r * (q + 1) + (xcd - r) * q) + off; }
        const int nig = WGM * nN, gid = wgid / nig, fm = gid * WGM, gsz = (nM - fm) < WGM ? (nM - fm) : WGM;
        u.pm = fm + ((wgid % nig) % gsz); u.pn = (wgid % nig) / gsz; u.e = 0; return true;
    }
};
struct MoeOrder {
    int t0, T, NC, G, c; const int* tile_e;
    __device__ bool next(int i, Unit& u) const {
        int tb = t0, Tx = T, per = G, loc = c;
        if (G % 8 == 0) { per = G / 8; const int x = c / per; loc = c - x * per; tb = t0 + (int)(((long)T * x) >> 3); Tx = t0 + (int)(((long)T * (x + 1)) >> 3) - tb; }
        const long L = (long)i * per + loc; if (L >= (long)Tx * NC) return false;
        const int gi = (int)(L / (4 * NC)), w = (int)(L % (4 * NC)), rem = Tx - gi * 4, gsz = rem < 4 ? rem : 4;
        u.pm = tb + gi * 4 + w % gsz; u.pn = w / gsz; u.e = tile_e[u.pm]; return true;
    }
};
typedef int i32x4 __attribute__((ext_vector_type(4)));
typedef int i32x8 __attribute__((ext_vector_type(8)));
template <int MODE> struct AccT { typedef f32x4 type; }; template <> struct AccT<1> { typedef i32x4 type; };
template <class Epi, class Sched, bool GATHER, bool ALIGN_EPI, int MODE = 0, bool DUAL = false>
__device__ __forceinline__ void gemm_phase(PG8_LAS unsigned char* lds, const Gemm g, const Sched& S, const Epi& E) {
    int tid = threadIdx.x; asm volatile("" : "+v"(tid));
    const int wid = __builtin_amdgcn_readfirstlane(tid >> 6), lane = tid & 63, wr = wid >> 2, wc = wid & 3, fr = lane & 15, fq = lane >> 4;
    const int KB = g.kb, nt = KB / 128; typedef typename AccT<MODE>::type accv; constexpr bool I8 = (MODE == 1), F8 = (MODE == 2);
    int sR[2], sC[2]; unsigned voffB[2], voffA[2];
#pragma unroll
    for (int i = 0; i < 2; ++i) { stage_rc(tid * 16 + i * 8192, sR[i], sC[i]); const int Rb = Epi::PERM ? ((sR[i] & ~31) + perm32(sR[i] & 31)) : sR[i]; voffB[i] = (unsigned)(Rb * KB + sC[i] * 2); voffA[i] = (unsigned)(sR[i] * g.lda_b + sC[i] * 2); }
    const size_t hstepA = (size_t)HALF * g.lda_b, tstepA = 2 * hstepA;
    const size_t kstep = (size_t)(BK * 2);
    const size_t hstepB = (size_t)HALF * KB;
    const unsigned ldsw = (unsigned)wid * 1024u;
    const int aoff = F8 ? lds_byte(wr * 64 + fr, fq * 16) : lds_byte(wr * 64 + fr, fq * 8), boff = F8 ? lds_byte(wc * 32 + fr, fq * 16) : lds_byte(wc * 32 + fr, fq * 8);
#define PG8_UOFF(dst, u) do { _Pragma("unroll") for (int h_ = 0; h_ < 2; ++h_) _Pragma("unroll") for (int i_ = 0; i_ < 2; ++i_) { int row_ = (u).pm * BM + h_ * HALF + sR[i_]; \
        if (GATHER) { row_ = g.rowidx[row_]; row_ = row_ < 0 ? 0 : row_; } dst[h_][i_] = (unsigned)(row_ * g.lda_b + sC[i_] * 2); } } while (0)
#define PG8_SA(b, h) (((b) * 2 + (h)) * HTB)
#define PG8_SB(b, h) ((4 + (b) * 2 + (h)) * HTB)
#define PG8_STAGE(bufoff, gbase, voff) do { _Pragma("unroll") for (int _i = 0; _i < 2; ++_i) \
        __builtin_amdgcn_global_load_lds((const unsigned*)((const char*)(gbase) + (voff)[_i]), (PG8_LAS unsigned*)(lds + (bufoff) + ldsw + _i * 8192), 16, 0, 0); } while (0)
#define PG8_STAGE_A(bufoff, kofs, hh, ubase, uoff) do { if constexpr (GATHER) { PG8_STAGE(bufoff, gA + (kofs), uoff[hh]); } else { PG8_STAGE(bufoff, (ubase) + (kofs) + (hh) * hstepA, voffA); } } while (0)
#define PG8_LDA(dst, b, h) do { if constexpr (F8) { _Pragma("unroll") for (int m = 0; m < 4; ++m) dst##8[m] = *(const PG8_LAS i32x8*)(lds + PG8_SA(b, h) + aoff + m * 2048); } \
        else { _Pragma("unroll") for (int m = 0; m < 4; ++m) _Pragma("unroll") for (int k = 0; k < 2; ++k) dst[m][k] = *(const PG8_LAS bf16x8*)(lds + PG8_SA(b, h) + aoff + m * 2048 + k * 1024); } } while (0)
#define PG8_LDB(dst, b, h) do { if constexpr (F8) { _Pragma("unroll") for (int n = 0; n < 2; ++n) dst##8[n] = *(const PG8_LAS i32x8*)(lds + PG8_SB(b, h) + boff + n * 2048); } \
        else { _Pragma("unroll") for (int n = 0; n < 2; ++n) _Pragma("unroll") for (int k = 0; k < 2; ++k) dst[n][k] = *(const PG8_LAS bf16x8*)(lds + PG8_SB(b, h) + boff + n * 2048 + k * 1024); } } while (0)
#define PG8_LDB1(dst, b, h) PG8_LDB(dst, b, h)
#define PG8_MMA(ai, bj, At, Bt) do { __builtin_amdgcn_s_setprio(1); _Pragma("unroll") for (int m = 0; m < 4; ++m) _Pragma("unroll") for (int n = 0; n < 2; ++n) { \
        if constexpr (F8) { asm volatile("v_mfma_f32_16x16x128_f8f6f4 %0, %1, %2, %0" : "+v"(acc[ai][bj][m][n]) : "v"(Bt##8[n]), "v"(At##8[m])); } \
        else { _Pragma("unroll") for (int k = 0; k < 2; ++k) { \
          if constexpr (I8) acc[ai][bj][m][n] = __builtin_amdgcn_mfma_i32_16x16x64_i8(__builtin_bit_cast(i32x4, Bt[n][k]), __builtin_bit_cast(i32x4, At[m][k]), acc[ai][bj][m][n], 0, 0, 0); \
          else acc[ai][bj][m][n] = __builtin_amdgcn_mfma_f32_16x16x32_bf16(Bt[n][k], At[m][k], acc[ai][bj][m][n], 0, 0, 0); } } } __builtin_amdgcn_s_setprio(0); } while (0)
#define PG8_WAIT_V(n) asm volatile("s_waitcnt vmcnt(" #n ")" ::: "memory")
#define PG8_WAIT_L(n) asm volatile("s_waitcnt lgkmcnt(" #n ")" ::: "memory")
#define PG8_BAR __builtin_amdgcn_s_barrier()
#define PG8_SCHED __builtin_amdgcn_sched_barrier(0)
    Unit cur, nxt; int ui = 0;
    if (!S.next(0, cur)) return;
    typename Epi::Early ev;
    accv acc[2][2][4][2];
#pragma unroll
    for (int a = 0; a < 2; ++a)
#pragma unroll
        for (int b = 0; b < 2; ++b)
#pragma unroll
            for (int m = 0; m < 4; ++m)
#pragma unroll
                for (int n = 0; n < 2; ++n) acc[a][b][m][n] = (accv){0, 0, 0, 0};
    bf16x8 At[4][2], B0[2][2], B1[2][2]; i32x8 At8[4], B08[2], B18[2];
    unsigned oA[2][2];
    if constexpr (GATHER) PG8_UOFF(oA, cur);
    const char* const gA = (const char*)g.A;
    const size_t ustepA = DUAL ? hstepA : tstepA;
    const char* cA = gA + (GATHER ? (size_t)0 : (size_t)cur.pm * ustepA);
    constexpr int BN = BM;
    const char* cB = (const char*)g.Bt + ((size_t)cur.e * g.b_erows + (size_t)cur.pn * BN) * KB;
    unsigned o0 = 0, o1 = 3 * HTB, o2 = 6 * HTB;
#define PG8_D3STAGE(off, ko, bA_, bB_) do { PG8_STAGE((off), (bB_) + (ko), voffB); PG8_STAGE((off) + HTB, (bB_) + hstepB + (ko), voffB); PG8_STAGE((off) + 2 * HTB, (bA_) + (ko), voffA); } while (0)
    if constexpr (DUAL) {
        PG8_D3STAGE(o0, 0, cA, cB); PG8_D3STAGE(o1, kstep, cA, cB);
        if (wr == 1) PG8_BAR;
        PG8_WAIT_V(6); PG8_BAR; PG8_BAR;
    } else {
    PG8_STAGE(PG8_SB(0, 0), cB, voffB); PG8_STAGE(PG8_SB(0, 1), cB + hstepB, voffB); PG8_STAGE_A(PG8_SA(0, 0), 0, 0, cA, oA); PG8_STAGE_A(PG8_SA(0, 1), 0, 1, cA, oA);
    if (wr == 1) PG8_BAR;
    PG8_WAIT_V(2); PG8_BAR;
    PG8_STAGE(PG8_SB(1, 0), cB + kstep, voffB); PG8_STAGE_A(PG8_SA(1, 0), kstep, 0, cA, oA); PG8_STAGE(PG8_SB(1, 1), cB + hstepB + kstep, voffB);
    PG8_WAIT_V(6); PG8_BAR;
    }
    PG8_LAS int* const ridx = (PG8_LAS int*)(lds + STAGE_BYTES + 4096);
    for (;;) {
        const bool has_next = S.next(ui + 1, nxt);
        const char* nA = (has_next && !GATHER) ? gA + (size_t)nxt.pm * ustepA : cA;
        const char* nB = has_next ? (const char*)g.Bt + ((size_t)nxt.e * g.b_erows + (size_t)nxt.pn * BN) * KB : cB;
        if constexpr (DUAL) {
#pragma unroll
            for (int s = 0; s < 2; ++s) {
#pragma unroll 1
                for (int kt = s * (nt / 2); kt < (s + 1) * (nt / 2); ++kt) {
                    const bool nx_ = (kt + 2 >= nt); const size_t ko_ = (size_t)(nx_ ? kt + 2 - nt : kt + 2) * kstep; const char* bA_ = nx_ ? nA : cA; const char* bB_ = nx_ ? nB : cB;
#pragma unroll
                    for (int n = 0; n < 2; ++n)
#pragma unroll
                        for (int k = 0; k < 2; ++k) { B0[n][k] = *(const PG8_LAS bf16x8*)(lds + o0 + boff + n * 2048 + k * 1024); B1[n][k] = *(const PG8_LAS bf16x8*)(lds + o0 + HTB + boff + n * 2048 + k * 1024); }
                    PG8_SCHED;
#pragma unroll
                    for (int m = 0; m < 4; ++m)
#pragma unroll
                        for (int k = 0; k < 2; ++k) At[m][k] = *(const PG8_LAS bf16x8*)(lds + o0 + 2 * HTB + aoff + m * 2048 + k * 1024);
                    PG8_D3STAGE(o2, ko_, bA_, bB_);
                    if (Epi::NEARLY > 0 && kt == nt - 1) { E.early(cur, wr, wc, fr, fq, ev); asm volatile("s_waitcnt vmcnt(%0)" :: "n"(6 + Epi::NEARLY) : "memory"); } else PG8_WAIT_V(6);
                    PG8_WAIT_L(0); PG8_BAR; PG8_MMA(s, 0, At, B0); PG8_MMA(s, 1, At, B1); PG8_BAR; PG8_SCHED;
                    const unsigned ot_ = o0; o0 = o1; o1 = o2; o2 = ot_;
                }
            }
        } else {
        constexpr int NS = 1; const int nh = nt;
#pragma unroll
        for (int s = 0; s < NS; ++s) {
#pragma unroll 1
        for (int t = s * nh; t < (s + 1) * nh; t += 2) {
            const bool last = (t == nt - 2);
            if constexpr (GATHER) { if (t == 0 && wid == 4) dma1k_(g.rowidx + (has_next ? nxt.pm : cur.pm) * BM + 4 * lane, (PG8_LAS unsigned char*)ridx); }
            if (last) E.pre(cur, lds + STAGE_BYTES, wid, lane);
            const size_t k1 = (size_t)(t + 1) * kstep, k2 = last ? (size_t)0 : (size_t)(t + 2) * kstep, k3 = k2 + kstep;
            const char* b2 = last ? nB : cB + (size_t)(t + 2) * kstep; const char* b3 = b2 + kstep;
            {
            PG8_LDB(B0, 0, 0); PG8_LDB(B1, 0, 1); PG8_SCHED; PG8_LDA(At, 0, 0); PG8_STAGE_A(PG8_SA(1, 1), k1, 1, cA, oA);
            if (last) { cA = nA;
                if constexpr (GATHER) {
#pragma unroll
                    for (int h_ = 0; h_ < 2; ++h_)
#pragma unroll
                        for (int i_ = 0; i_ < 2; ++i_) { int row_ = ridx[h_ * HALF + sR[i_]]; row_ = row_ < 0 ? 0 : row_; oA[h_][i_] = (unsigned)(row_ * g.lda_b + sC[i_] * 2); } } }
            PG8_WAIT_V(8); PG8_WAIT_L(0); PG8_BAR; PG8_MMA(0, 0, At, B0); PG8_MMA(0, 1, At, B1); PG8_BAR; PG8_SCHED;
            PG8_LDA(At, 0, 1); PG8_STAGE(PG8_SB(0, 0), b2, voffB); PG8_STAGE(PG8_SB(0, 1), b2 + hstepB, voffB); PG8_STAGE_A(PG8_SA(0, 0), k2, 0, cA, oA);
            PG8_WAIT_V(8); PG8_WAIT_L(0); PG8_BAR; PG8_MMA(1, 0, At, B0); PG8_MMA(1, 1, At, B1); PG8_BAR; PG8_SCHED;
            PG8_LDB(B0, 1, 0); PG8_LDB(B1, 1, 1); PG8_SCHED; PG8_LDA(At, 1, 0); PG8_STAGE_A(PG8_SA(0, 1), k2, 1, cA, oA);
            PG8_WAIT_V(8); PG8_WAIT_L(0); PG8_BAR; PG8_MMA(0, 0, At, B0); PG8_MMA(0, 1, At, B1); PG8_BAR; PG8_SCHED;
            PG8_LDA(At, 1, 1); PG8_STAGE(PG8_SB(1, 0), b3, voffB); PG8_STAGE(PG8_SB(1, 1), b3 + hstepB, voffB); PG8_STAGE_A(PG8_SA(1, 0), k3, 0, cA, oA);
            if (Epi::NEARLY > 0 && last) { E.early(cur, wr, wc, fr, fq, ev); asm volatile("s_waitcnt vmcnt(%0)" :: "n"(8 + Epi::NEARLY) : "memory"); } else PG8_WAIT_V(8);
            PG8_WAIT_L(0); PG8_BAR; PG8_MMA(1, 0, At, B0); PG8_MMA(1, 1, At, B1); PG8_BAR; PG8_SCHED;
            }
        }
        }
        }
        if constexpr (ALIGN_EPI) { if (wr == 0) PG8_BAR; }
        if constexpr (F8) asm volatile("s_nop 15\n\ts_nop 15" ::: "memory");
        if constexpr (Epi::NEARLY > 0) E.with_early(acc, cur, wr, wc, fr, fq, lds + STAGE_BYTES, ev); else E(acc, cur, wr, wc, fr, fq, lds + STAGE_BYTES);
        if (!has_next) break;
#pragma unroll
        for (int a = 0; a < 2; ++a)
#pragma unroll
            for (int b = 0; b < 2; ++b)
#pragma unroll
                for (int m = 0; m < 4; ++m)
#pragma unroll
                    for (int n = 0; n < 2; ++n) acc[a][b][m][n] = (accv){0, 0, 0, 0};
        cur = nxt; cB = nB; ++ui;
        if constexpr (DUAL) cA = nA;
        if constexpr (ALIGN_EPI) { if (wr == 1) PG8_BAR; }
    }
    PG8_WAIT_V(0);
    if constexpr (!ALIGN_EPI) { if (wr == 0) PG8_BAR; }
    PG8_BAR;
#undef PG8_UOFF
#undef PG8_SA
#undef PG8_SB
#undef PG8_STAGE
#undef PG8_STAGE_A
#undef PG8_LDA
#undef PG8_LDB
#undef PG8_LDB1
#undef PG8_D3STAGE
#undef PG8_MMA
#undef PG8_WAIT_V
#undef PG8_WAIT_L
#undef PG8_BAR
#undef PG8_SCHED
}
typedef f32x4 Acc[2][2][4][2];
typedef PG8_LAS unsigned char* SpP;
__device__ __forceinline__ void dma1k(const void* g  , SpP dst) { __builtin_amdgcn_global_load_lds((const unsigned*)g, (PG8_LAS unsigned*)dst, 16, 0, 0); }
__device__ __forceinline__ u32x4 pack8(const f32x4& v0, const f32x4& v1) { u32x4 w; w.x = cvtpk(v0[0], v0[1]); w.y = cvtpk(v0[2], v0[3]); w.z = cvtpk(v1[0], v1[1]); w.w = cvtpk(v1[2], v1[3]); return w; }
__device__ __forceinline__ void unpack8(const u32x4& w, f32x4& v0, f32x4& v1) { v0[0] = bf2f(w.x & 0xffff); v0[1] = bf2f(w.x >> 16); v0[2] = bf2f(w.y & 0xffff); v0[3] = bf2f(w.y >> 16); v1[0] = bf2f(w.z & 0xffff); v1[1] = bf2f(w.z >> 16); v1[2] = bf2f(w.w & 0xffff); v1[3] = bf2f(w.w >> 16); }
struct EpiInProjF {
    static constexpr bool PERM = true;
    bf16_t* proj; bf16_t* gate; const float* bgate; const float* rope;
    __device__ __forceinline__ void operator()(const Acc& acc, const Unit& u, int wr, int wc, int fr, int fq, SpP sp) const {
        const int row0 = u.pm * BM + wr * 64 + fr, colt = u.pn * BM + wc * 32 + 8 * fq; const bool isg = colt >= PROJ_NC;
        if (u.pn < 4 && (wc & 1) == 0) {
            const float sgn = fq == 0 ? -1.0f : 1.0f; const bool rot = fq < 2;
#pragma unroll
            for (int ai = 0; ai < 2; ++ai)
#pragma unroll
                for (int m = 0; m < 4; ++m) { const size_t row = (size_t)(row0 + ai * HALF + m * 16); const int pos = (int)(row & (SEQ - 1));
                    (void)pos; const int rl = (wr * 64 + fr + ai * HALF + m * 16) * 32;
                    const f32x4 c0 = *(const PG8_LAS f32x4*)(sp + 8192 + rl), c1 = *(const PG8_LAS f32x4*)(sp + 8192 + rl + 16), s0 = *(const PG8_LAS f32x4*)(sp + 16384 + rl), s1 = *(const PG8_LAS f32x4*)(sp + 16384 + rl + 16);
#pragma unroll
                    for (int bj = 0; bj < 2; ++bj) { f32x4 v0 = acc[ai][bj][m][0], v1 = acc[ai][bj][m][1], q0, q1;
#pragma unroll
                        for (int k = 0; k < 4; ++k) { q0[k] = __shfl_xor(v0[k], 16); q1[k] = __shfl_xor(v1[k], 16); }
                        if (rot) { v0 = v0 * c0 + q0 * s0 * sgn; v1 = v1 * c1 + q1 * s1 * sgn; }
                        *(u32x4*)(proj + row * PROJ_LD + colt + bj * HALF) = pack8(v0, v1); } }
            return;
        }
#pragma unroll
        for (int bj = 0; bj < 2; ++bj) { const int col = colt + bj * HALF; f32x4 b0 = (f32x4){0.f, 0.f, 0.f, 0.f}, b1 = b0;
            if (isg) { b0 = *(const PG8_LAS f32x4*)(sp + 2048 + (bj * HALF + wc * 32 + 8 * fq) * 4) * -1.4426950408889634f; b1 = *(const PG8_LAS f32x4*)(sp + 2048 + (bj * HALF + wc * 32 + 8 * fq) * 4 + 16) * -1.4426950408889634f; }
#pragma unroll
            for (int ai = 0; ai < 2; ++ai)
#pragma unroll
                for (int m = 0; m < 4; ++m) { const size_t row = (size_t)(row0 + ai * HALF + m * 16); f32x4 v0 = acc[ai][bj][m][0], v1 = acc[ai][bj][m][1];
                    if (isg) { v0 += b0; v1 += b1;
#pragma unroll
                        for (int k = 0; k < 4; ++k) { v0[k] = __builtin_amdgcn_rcpf(1.0f + __builtin_amdgcn_exp2f(v0[k])); v1[k] = __builtin_amdgcn_rcpf(1.0f + __builtin_amdgcn_exp2f(v1[k])); }
                        u32x2 gw;
                        { unsigned q0 = __float_as_uint(__builtin_fmaf(v0[0], 255.f, 8388608.f)), q1 = __float_as_uint(__builtin_fmaf(v0[1], 255.f, 8388608.f)), q2 = __float_as_uint(__builtin_fmaf(v0[2], 255.f, 8388608.f)), q3 = __float_as_uint(__builtin_fmaf(v0[3], 255.f, 8388608.f));
                          gw.x = __builtin_amdgcn_perm(__builtin_amdgcn_perm(q3, q2, 0x0c0c0400u), __builtin_amdgcn_perm(q1, q0, 0x0c0c0400u), 0x05040100u);
                          q0 = __float_as_uint(__builtin_fmaf(v1[0], 255.f, 8388608.f)); q1 = __float_as_uint(__builtin_fmaf(v1[1], 255.f, 8388608.f)); q2 = __float_as_uint(__builtin_fmaf(v1[2], 255.f, 8388608.f)); q3 = __float_as_uint(__builtin_fmaf(v1[3], 255.f, 8388608.f));
                          gw.y = __builtin_amdgcn_perm(__builtin_amdgcn_perm(q3, q2, 0x0c0c0400u), __builtin_amdgcn_perm(q1, q0, 0x0c0c0400u), 0x05040100u); }
                        *(u32x2*)((unsigned char*)gate + row * GATE_LD + col - PROJ_NC) = gw; }
                    else *(u32x4*)(proj + row * PROJ_LD + col) = pack8(v0, v1); } }
    }
};
struct EpiInProjI {
    struct Early {}; static constexpr int NEARLY = 0; __device__ __forceinline__ void early(const Unit&, int, int, int, int, Early&) const {}
    static constexpr bool PERM = true;
    EpiInProjF f; const float* sx; const float* sw;
    __device__ __forceinline__ void pre(const Unit& u, SpP sp, int wid, int lane) const {
        if (wid == 0) dma1k(sx + u.pm * BM + 4 * lane, sp); else if (wid == 1) dma1k(sw + u.pn * BM + 4 * lane, sp + 1024);
        else if (wid == 2 && u.pn * BM >= PROJ_NC) dma1k(f.bgate + u.pn * BM - PROJ_NC + 4 * lane, sp + 2048);
        if (u.pn < 4) { const float* rp = f.rope + (size_t)((u.pm * BM) & (SEQ - 1)) * 8 + wid * 256 + 4 * lane;
            dma1k(rp, sp + 8192 + wid * 1024); dma1k(rp + SEQ * 8, sp + 16384 + wid * 1024); }
    }
    __device__ __forceinline__ void operator()(const i32x4 (&acc)[2][2][4][2], const Unit& u, int wr, int wc, int fr, int fq, SpP sp) const {
        Acc v; const float gsc = (u.pn * BM >= PROJ_NC) ? -1.4426950408889634f : 1.0f;
#pragma unroll
        for (int ai = 0; ai < 2; ++ai)
#pragma unroll
            for (int m = 0; m < 4; ++m) { const float sr = *(const PG8_LAS float*)(sp + (wr * 64 + fr + ai * HALF + m * 16) * 4) * gsc;
#pragma unroll
                for (int bj = 0; bj < 2; ++bj) { const PG8_LAS f32x4* cp = (const PG8_LAS f32x4*)(sp + 1024 + (bj * HALF + wc * 32 + 8 * fq) * 4); const f32x4 c0 = cp[0] * sr, c1 = cp[1] * sr;
#pragma unroll
                    for (int k = 0; k < 4; ++k) { v[ai][bj][m][0][k] = (float)acc[ai][bj][m][0][k] * c0[k]; v[ai][bj][m][1][k] = (float)acc[ai][bj][m][1][k] * c1[k]; } } }
        f(v, u, wr, wc, fr, fq, sp);
    }
};
struct EpiProjF {
    static constexpr bool PERM = true;
    const bf16_t* gate; bf16_t* merged; int first; int pad_;
    __device__ __forceinline__ void pre(const Unit&, SpP, int, int) const {}
    __device__ __forceinline__ void operator()(const Acc& acc, const Unit& u, int wr, int wc, int fr, int fq, SpP) const {
        const int row0 = u.pm * BM + wr * 64 + fr, colt = u.pn * BM + wc * 32 + 8 * fq;
        const unsigned char* gp = (const unsigned char*)gate + (size_t)row0 * GATE_LD + (first ? 0 : DM) + colt; bf16_t* mp = merged + (size_t)row0 * DM + colt;
        constexpr int D = 4; u32x2 gw[16]; u32x4 pv[16];
#define PROJ_OFF(i) ((((i) >> 2) & 1) * HALF + ((i) & 3) * 16)
#define PROJ_LD_(i) do { gw[i] = *(const u32x2*)(gp + (size_t)PROJ_OFF(i) * GATE_LD + ((i) >> 3) * HALF); if (!first) pv[i] = *(const u32x4*)(mp + (size_t)PROJ_OFF(i) * DM + ((i) >> 3) * HALF); } while (0)
#pragma unroll
        for (int i = 0; i < D; ++i) PROJ_LD_(i);
#pragma unroll
        for (int i = 0; i < 16; ++i) { if (i + D < 16) PROJ_LD_(i + D);
            __builtin_amdgcn_sched_barrier(0);
            const int bj = i >> 3, ai = (i >> 2) & 1, m = i & 3; f32x4 g0, g1;
#pragma unroll
            for (int k = 0; k < 4; ++k) { g0[k] = (float)((gw[i].x >> (8 * k)) & 0xffu) * (1.0f / 255.0f); g1[k] = (float)((gw[i].y >> (8 * k)) & 0xffu) * (1.0f / 255.0f); }
            f32x4 v0 = acc[ai][bj][m][0] * g0, v1 = acc[ai][bj][m][1] * g1;
            if (!first) { f32x4 p0, p1; unpack8(pv[i], p0, p1); v0 += p0; v1 += p1; }
            *(u32x4*)(mp + (size_t)PROJ_OFF(i) * DM + bj * HALF) = pack8(v0, v1);
            __builtin_amdgcn_sched_barrier(0); }
#undef PROJ_OFF
#undef PROJ_LD_
    }
};
struct EpiProj2 {
    static constexpr bool PERM = true;
    struct Early { u32x2 ga[4], gb[4]; }; static constexpr int NEARLY = 8;
    const unsigned char* gate; bf16_t* merged;
    __device__ __forceinline__ void pre(const Unit&, SpP, int, int) const {}
    __device__ __forceinline__ void early(const Unit& u, int wr, int wc, int fr, int fq, Early& ev) const {
        const unsigned char* gp = gate + (size_t)(u.pm * HALF + wr * 64 + fr) * GATE_LD + u.pn * BM + wc * 32 + 8 * fq;
#pragma unroll
        for (int i = 0; i < 4; ++i) { const size_t ro = (size_t)((i & 3) * 16) * GATE_LD + (i >> 2) * HALF; ev.ga[i] = *(const u32x2*)(gp + ro); ev.gb[i] = *(const u32x2*)(gp + ro + DM); }
    }
    __device__ __forceinline__ void with_early(const Acc& acc, const Unit& u, int wr, int wc, int fr, int fq, SpP, const Early& ev) const {
        const int row0 = u.pm * HALF + wr * 64 + fr, colt = u.pn * BM + wc * 32 + 8 * fq;
        bf16_t* mp = merged + (size_t)row0 * DM + colt; const unsigned char* gp = gate + (size_t)row0 * GATE_LD + colt;
        u32x2 ga[8], gb[8];
#pragma unroll
        for (int i = 0; i < 4; ++i) { ga[i] = ev.ga[i]; gb[i] = ev.gb[i]; }
#pragma unroll
        for (int i = 4; i < 8; ++i) { const size_t ro = (size_t)((i & 3) * 16) * GATE_LD + (i >> 2) * HALF; ga[i] = *(const u32x2*)(gp + ro); gb[i] = *(const u32x2*)(gp + ro + DM); }
#pragma unroll
        for (int i = 0; i < 8; ++i) { const int bj = i >> 2, m = i & 3; f32x4 a0, a1, b0, b1;
#pragma unroll
            for (int k = 0; k < 4; ++k) { a0[k] = (float)((ga[i].x >> (8 * k)) & 0xffu) * (1.0f / 255.0f); a1[k] = (float)((ga[i].y >> (8 * k)) & 0xffu) * (1.0f / 255.0f);
                                          b0[k] = (float)((gb[i].x >> (8 * k)) & 0xffu) * (1.0f / 255.0f); b1[k] = (float)((gb[i].y >> (8 * k)) & 0xffu) * (1.0f / 255.0f); }
            const f32x4 v0 = acc[0][bj][m][0] * a0 + acc[1][bj][m][0] * b0, v1 = acc[0][bj][m][1] * a1 + acc[1][bj][m][1] * b1;
            *(u32x4*)(mp + (size_t)(m * 16) * DM + bj * HALF) = pack8(v0, v1); }
    }
    __device__ __forceinline__ void operator()(const Acc& acc, const Unit& u, int wr, int wc, int fr, int fq, SpP sp) const { Early ev; early(u, wr, wc, fr, fq, ev); with_early(acc, u, wr, wc, fr, fq, sp, ev); }
};
struct EpiWoutF {
    static constexpr bool PERM = true;
    const float* x; bf16_t* x1; const float* g2; unsigned* amax;
    struct Early { f32x4 r0[4]; }; static constexpr int NEARLY = 4;
    __device__ __forceinline__ void pre(const Unit&, SpP, int, int) const {}
    __device__ __forceinline__ void early(const Unit& u, int wr, int wc, int fr, int fq, Early& ev) const {
        const float* xp = x + (size_t)(u.pm * BM + wr * 64 + fr) * DM + u.pn * BM + wc * 32 + 8 * fq;
        ev.r0[0] = *(const f32x4*)xp; ev.r0[1] = *(const f32x4*)(xp + 4); ev.r0[2] = *(const f32x4*)(xp + HALF); ev.r0[3] = *(const f32x4*)(xp + HALF + 4);
    }
    __device__ __forceinline__ void operator()(const Acc& acc, const Unit& u, int wr, int wc, int fr, int fq, SpP sp) const { Early ev; early(u, wr, wc, fr, fq, ev); with_early(acc, u, wr, wc, fr, fq, sp, ev); }
    __device__ __forceinline__ void with_early(const Acc& acc, const Unit& u, int wr, int wc, int fr, int fq, SpP, const Early& ev) const {
        const int row0 = u.pm * BM + wr * 64 + fr, colt = u.pn * BM + wc * 32 + 8 * fq;
        f32x4 gg[2][2];
#pragma unroll
        for (int bj = 0; bj < 2; ++bj)
#pragma unroll
            for (int n = 0; n < 2; ++n) gg[bj][n] = *(const f32x4*)(g2 + colt + bj * HALF + n * 4);
        f32x4 xb[8][4];
#define WOUT_LD(r) do { const float* xp_ = x + (size_t)(row0 + ((r) >> 2) * HALF + ((r) & 3) * 16) * DM + colt; xb[r][0] = *(const f32x4*)xp_; xb[r][1] = *(const f32x4*)(xp_ + 4); xb[r][2] = *(const f32x4*)(xp_ + HALF); xb[r][3] = *(const f32x4*)(xp_ + HALF + 4); } while (0)
#pragma unroll
        for (int j = 0; j < 4; ++j) xb[0][j] = ev.r0[j];
        WOUT_LD(1);
#pragma unroll
        for (int r = 0; r < 8; ++r) { if (r + 2 < 8) WOUT_LD(r + 2);
            __builtin_amdgcn_sched_barrier(0);
            const int ai = r >> 2, m = r & 3; const int row = row0 + ai * HALF + m * 16; float am = 0.f;
#pragma unroll
            for (int bj = 0; bj < 2; ++bj) { const u32x4 pk = pack8(xb[r][2 * bj] + acc[ai][bj][m][0], xb[r][2 * bj + 1] + acc[ai][bj][m][1]);
                *(u32x4*)(x1 + (size_t)row * DM + colt + bj * HALF) = pk;
                f32x4 r0, r1; unpack8(pk, r0, r1); const f32x4 h0 = r0 * gg[bj][0], h1 = r1 * gg[bj][1];
                am = __builtin_fmaxf(am, __builtin_fmaxf(__builtin_fmaxf(__builtin_fabsf(h0[0]), __builtin_fabsf(h0[1])), __builtin_fmaxf(__builtin_fabsf(h0[2]), __builtin_fabsf(h0[3]))));
                am = __builtin_fmaxf(am, __builtin_fmaxf(__builtin_fmaxf(__builtin_fabsf(h1[0]), __builtin_fabsf(h1[1])), __builtin_fmaxf(__builtin_fabsf(h1[2]), __builtin_fabsf(h1[3])))); }
            am = __builtin_fmaxf(am, __shfl_xor(am, 16)); am = __builtin_fmaxf(am, __shfl_xor(am, 32));
            if (fq == 0) atomicMax(amax + row, __float_as_uint(am));
            __builtin_amdgcn_sched_barrier(0); }
#undef WOUT_LD
    }
};
struct EpiMoe1F {
    static constexpr bool PERM = true;
    bf16_t* act; const float* b1; const int* stok; const float* rnorm; int tile0; int pad_;
    __device__ __forceinline__ void operator()(const Acc& acc, const Unit& u, int wr, int wc, int fr, int fq) const {
        const int row0 = (u.pm - tile0) * BM + wr * 64 + fr, c = u.pn * HALF + wc * 32 + 8 * fq;
        const float* bg = b1 + (size_t)u.e * 2048 + c; const f32x4 bg0 = *(const f32x4*)bg, bg1 = *(const f32x4*)(bg + 4), bl0 = *(const f32x4*)(bg + 1024), bl1 = *(const f32x4*)(bg + 1028);
#pragma unroll
        for (int ai = 0; ai < 2; ++ai)
#pragma unroll
            for (int m = 0; m < 4; ++m) { f32x4 o0, o1; const int tk = stok[u.pm * BM + wr * 64 + fr + ai * HALF + m * 16]; const float rs = tk >= 0 ? rnorm[tk] : 0.f;
#pragma unroll
                for (int k = 0; k < 4; ++k) {
                    { const float glu = fminf(acc[ai][0][m][0][k] * rs + bg0[k], 7.0f), lin = fminf(fmaxf(acc[ai][1][m][0][k] * rs + bl0[k], -7.0f), 7.0f); o0[k] = glu * sigmoidf_(1.702f * glu) * (lin + 1.0f); }
                    { const float glu = fminf(acc[ai][0][m][1][k] * rs + bg1[k], 7.0f), lin = fminf(fmaxf(acc[ai][1][m][1][k] * rs + bl1[k], -7.0f), 7.0f); o1[k] = glu * sigmoidf_(1.702f * glu) * (lin + 1.0f); } }
                *(u32x4*)(act + (size_t)(row0 + ai * HALF + m * 16) * DM + c) = pack8(o0, o1); }
    }
};
struct EpiMoe1I {
    struct Early {}; static constexpr int NEARLY = 0; __device__ __forceinline__ void early(const Unit&, int, int, int, int, Early&) const {}
    static constexpr bool PERM = true;
    bf16_t* act; const float* b1; const float* rss; const float* sw1; int tile0; int pad_;
    __device__ __forceinline__ void pre(const Unit& u, SpP sp, int wid, int lane) const {
        if (wid == 0) dma1k(rss + u.pm * BM + 4 * lane, sp); else if (wid == 1) dma1k(sw1 + (size_t)u.e * 2048 + u.pn * BM + 4 * lane, sp + 1024);
        else if (wid == 2) dma1k(b1 + (size_t)u.e * 2048 + (lane >> 5) * 1024 + u.pn * HALF + 4 * (lane & 31), sp + 2048);
    }
    __device__ __forceinline__ void operator()(const i32x4 (&acc)[2][2][4][2], const Unit& u, int wr, int wc, int fr, int fq, SpP sp) const {
        const int row0 = (u.pm - tile0) * BM + wr * 64 + fr, c = u.pn * HALF + wc * 32 + 8 * fq, cl = (wc * 32 + 8 * fq) * 4;
        const f32x4 bg0 = *(const PG8_LAS f32x4*)(sp + 2048 + cl), bg1 = *(const PG8_LAS f32x4*)(sp + 2048 + cl + 16), bl0 = *(const PG8_LAS f32x4*)(sp + 2560 + cl), bl1 = *(const PG8_LAS f32x4*)(sp + 2560 + cl + 16);
        const f32x4 sg0 = *(const PG8_LAS f32x4*)(sp + 1024 + cl), sg1 = *(const PG8_LAS f32x4*)(sp + 1024 + cl + 16), sl0 = *(const PG8_LAS f32x4*)(sp + 1536 + cl), sl1 = *(const PG8_LAS f32x4*)(sp + 1536 + cl + 16);
#pragma unroll
        for (int ai = 0; ai < 2; ++ai)
#pragma unroll
            for (int m = 0; m < 4; ++m) { f32x4 o0, o1; const float rs = *(const PG8_LAS float*)(sp + (wr * 64 + fr + ai * HALF + m * 16) * 4);
#pragma unroll
                for (int k = 0; k < 4; ++k) {
                    { const float glu = fminf((float)acc[ai][0][m][0][k] * (rs * sg0[k]) + bg0[k], 7.0f), lin = fminf(fmaxf((float)acc[ai][1][m][0][k] * (rs * sl0[k]) + bl0[k], -7.0f), 7.0f); o0[k] = glu * sigmoidf_(1.702f * glu) * __builtin_fmaf(lin, 4.0f, 4.0f); }
                    { const float glu = fminf((float)acc[ai][0][m][1][k] * (rs * sg1[k]) + bg1[k], 7.0f), lin = fminf(fmaxf((float)acc[ai][1][m][1][k] * (rs * sl1[k]) + bl1[k], -7.0f), 7.0f); o1[k] = glu * sigmoidf_(1.702f * glu) * __builtin_fmaf(lin, 4.0f, 4.0f); } }
                unsigned w0 = __builtin_amdgcn_cvt_pk_fp8_f32(o0[0], o0[1], 0, false); w0 = __builtin_amdgcn_cvt_pk_fp8_f32(o0[2], o0[3], w0, true);
                unsigned w1 = __builtin_amdgcn_cvt_pk_fp8_f32(o1[0], o1[1], 0, false); w1 = __builtin_amdgcn_cvt_pk_fp8_f32(o1[2], o1[3], w1, true);
                u32x2 w; w.x = w0; w.y = w1; *(u32x2*)((unsigned char*)act + (size_t)(row0 + ai * HALF + m * 16) * DM + c) = w; }
    }
};
struct EpiMoe2F {
    struct Early {}; static constexpr int NEARLY = 0; __device__ __forceinline__ void early(const Unit&, int, int, int, int, Early&) const {}
    static constexpr bool PERM = true;
    bf16_t* y; const float* b2; const int* rdst; const float* rgate; const float* sw2;
    __device__ __forceinline__ void pre(const Unit& u, SpP sp, int wid, int lane) const {
        if (wid == 0) dma1k(rdst + u.pm * BM + 4 * lane, sp); else if (wid == 1) dma1k(rgate + u.pm * BM + 4 * lane, sp + 1024);
        else if (wid == 2) dma1k(b2 + (size_t)u.e * DM + u.pn * BM + 4 * lane, sp + 2048); else if (wid == 3) dma1k(sw2 + (size_t)u.e * DM + u.pn * BM + 4 * lane, sp + 3072);
    }
    __device__ __forceinline__ void operator()(const Acc& acc, const Unit& u, int wr, int wc, int fr, int fq, SpP sp) const {
        const int colt = u.pn * BM + wc * 32 + 8 * fq, cl = (wc * 32 + 8 * fq) * 4;
        f32x4 cs_[2][2], cb_[2][2];
#pragma unroll
        for (int bj = 0; bj < 2; ++bj) { const PG8_LAS f32x4* bp = (const PG8_LAS f32x4*)(sp + 2048 + bj * 512 + cl); const PG8_LAS f32x4* sq = (const PG8_LAS f32x4*)(sp + 3072 + bj * 512 + cl);
            cs_[bj][0] = sq[0] * 0.25f; cs_[bj][1] = sq[1] * 0.25f; cb_[bj][0] = bp[0]; cb_[bj][1] = bp[1]; }
#pragma unroll
        for (int ai = 0; ai < 2; ++ai)
#pragma unroll
            for (int m = 0; m < 4; ++m) { const int lr = (wr * 64 + fr + ai * HALF + m * 16) * 4; const int dst = *(const PG8_LAS int*)(sp + lr); if (dst < 0) continue; const float gt8 = *(const PG8_LAS float*)(sp + 1024 + lr) * 8.0f;
#pragma unroll
                for (int bj = 0; bj < 2; ++bj) { const int col = colt + bj * HALF;
                    f32x4 y0 = (acc[ai][bj][m][0] * cs_[bj][0] + cb_[bj][0]) * gt8, y1 = (acc[ai][bj][m][1] * cs_[bj][1] + cb_[bj][1]) * gt8;
#pragma unroll
                    for (int k = 0; k < 4; ++k) { y0[k] = __builtin_amdgcn_fmed3f(y0[k], -448.f, 448.f); y1[k] = __builtin_amdgcn_fmed3f(y1[k], -448.f, 448.f); }
                    unsigned w0 = __builtin_amdgcn_cvt_pk_fp8_f32(y0[0], y0[1], 0, false); w0 = __builtin_amdgcn_cvt_pk_fp8_f32(y0[2], y0[3], w0, true);
                    unsigned w1 = __builtin_amdgcn_cvt_pk_fp8_f32(y1[0], y1[1], 0, false); w1 = __builtin_amdgcn_cvt_pk_fp8_f32(y1[2], y1[3], w1, true);
                    u32x2 w; w.x = w0; w.y = w1; *(u32x2*)((unsigned char*)y + (size_t)dst * DM + col) = w; } }
    }
};
}

struct Params {
    const float *x, *norm1_g, *w_in, *w_proj_a, *w_proj_b, *w_gate, *b_gate, *w_out, *norm2_g, *w_router, *b_router, *w1, *b1, *w2, *b2, *norm_f_g;
    float* out; char* ws; RopeF fr;
};

__device__ __forceinline__ void p0_transpose_item(const float* __restrict__ W, int K, int N, bf16_t* __restrict__ WT, int ldt  , LAS float* scr, int item, int lane) {
    const int nblk = N / 32, kb = item / nblk, nb = item % nblk, k0 = 64 * kb, n0 = 32 * nb;
#pragma unroll 8
    for (int i = 0; i < 32; ++i) { const int kk = 2 * i + (lane >> 5); scr[kk * 33 + (lane & 31)] = W[(size_t)(k0 + kk) * N + n0 + (lane & 31)]; }
    WAVE_FENCE();
    const int c = lane & 7;
#pragma unroll
    for (int j = 0; j < 4; ++j) { const int n = (lane >> 3) + 8 * j; const LAS float* sp = scr + (8 * c) * 33 + n;
        u32x4 o; o.x = cvtpk(sp[0 * 33], sp[1 * 33]); o.y = cvtpk(sp[2 * 33], sp[3 * 33]); o.z = cvtpk(sp[4 * 33], sp[5 * 33]); o.w = cvtpk(sp[6 * 33], sp[7 * 33]);
        *(u32x4*)(WT + (size_t)(n0 + n) * ldt + k0 + 8 * c) = o; }
    WAVE_FENCE();
}

template <int F8>
__device__ __forceinline__ void p0_quant_item(const float* __restrict__ W, int N, signed char* __restrict__ Wq, float* __restrict__ sw, int mode, int n0, LAS char* scr, int lane) {
    constexpr float QMAX = F8 ? 448.0f : 127.0f;
    const int n4 = lane & 7, kr = lane >> 3; const float* wp = W + (size_t)kr * N + n0 + 4 * n4;
    f32x4 mx = (f32x4){0.f, 0.f, 0.f, 0.f};
#pragma unroll 8
    for (int i = 0; i < 128; ++i) { const f32x4 v = *(const f32x4*)(wp + (size_t)(8 * i) * N);
#pragma unroll
        for (int j = 0; j < 4; ++j) mx[j] = __builtin_fmaxf(mx[j], __builtin_fabsf(v[j])); }
#pragma unroll
    for (int o = 8; o < 64; o <<= 1)
#pragma unroll
        for (int j = 0; j < 4; ++j) mx[j] = __builtin_fmaxf(mx[j], __shfl_xor(mx[j], o));
    f32x4 qs;
#pragma unroll
    for (int j = 0; j < 4; ++j) qs[j] = mx[j] > 0.f ? QMAX / mx[j] : 0.f;
    const int npb = mode ? w1map(n0) : n0;
    if (kr == 0) *(f32x4*)(sw + npb + 4 * n4) = mx * (1.0f / QMAX);
#pragma unroll 1
    for (int c = 0; c < 8; ++c) {
        WAVE_FENCE();
#pragma unroll 4
        for (int i = 0; i < 16; ++i) { const f32x4 v = *(const f32x4*)(wp + (size_t)(128 * c + 8 * i) * N);
#pragma unroll
            for (int j = 0; j < 4; ++j) { const float t = v[j] * qs[j];
                *(LAS signed char*)(scr + (4 * n4 + j) * 144 + 8 * i + kr) = F8 ? (signed char)(__builtin_amdgcn_cvt_pk_fp8_f32(t, t, 0, false) & 0xff) : (signed char)(int)__builtin_rintf(t); } }
        WAVE_FENCE();
#pragma unroll
        for (int t = 0; t < 4; ++t) { const int id = lane + 64 * t, row = id >> 3, ch = id & 7;
            *(u32x4*)(Wq + (size_t)(npb + row) * 1024 + 128 * c + 16 * ch) = *(const LAS u32x4*)(scr + row * 144 + ch * 16); }
    }
    WAVE_FENCE();
}

template <int F8>
__device__ __forceinline__ void p0_quant_block(const float* __restrict__ W, int N, signed char* __restrict__ Wq, float* __restrict__ sw, int mode, int n0, LAS char* scr, LAS float* xch, int wid, int lane, float ssc = 1.0f  ) {
    constexpr float QMAX = F8 ? 448.0f : 127.0f;
    const int n4 = lane & 7, kr = lane >> 3; const float* wp = W + (size_t)(128 * wid + kr) * N + n0 + 4 * n4;
    f32x4 v[16]; f32x4 mx = (f32x4){0.f, 0.f, 0.f, 0.f};
#pragma unroll
    for (int i = 0; i < 16; ++i) v[i] = *(const f32x4*)(wp + (size_t)(8 * i) * N);
#pragma unroll
    for (int i = 0; i < 16; ++i)
#pragma unroll
        for (int j = 0; j < 4; ++j) mx[j] = __builtin_fmaxf(mx[j], __builtin_fabsf(v[i][j]));
#pragma unroll
    for (int o = 8; o < 64; o <<= 1)
#pragma unroll
        for (int j = 0; j < 4; ++j) mx[j] = __builtin_fmaxf(mx[j], __shfl_xor(mx[j], o));
    if (kr == 0) *(LAS f32x4*)(xch + wid * 32 + 4 * n4) = mx;
    __syncthreads();
#pragma unroll
    for (int w = 0; w < 8; ++w) { const f32x4 o = *(const LAS f32x4*)(xch + w * 32 + 4 * n4);
#pragma unroll
        for (int j = 0; j < 4; ++j) mx[j] = __builtin_fmaxf(mx[j], o[j]); }
    f32x4 qs;
#pragma unroll
    for (int j = 0; j < 4; ++j) qs[j] = mx[j] > 0.f ? QMAX / mx[j] : 0.f;
    const int npb = mode ? w1map(n0) : n0;
    if (wid == 0 && kr == 0) *(f32x4*)(sw + npb + 4 * n4) = mx * ((1.0f / QMAX) * ssc);
    WAVE_FENCE();
#pragma unroll
    for (int i = 0; i < 16; ++i)
#pragma unroll
        for (int j = 0; j < 4; ++j) { const float t = v[i][j] * qs[j];
            *(LAS signed char*)(scr + (4 * n4 + j) * 144 + 8 * i + kr) = F8 ? (signed char)(__builtin_amdgcn_cvt_pk_fp8_f32(t, t, 0, false) & 0xff) : (signed char)(int)__builtin_rintf(t); }
    WAVE_FENCE();
#pragma unroll
    for (int t = 0; t < 4; ++t) { const int id = lane + 64 * t, row = id >> 3, ch = id & 7;
        *(u32x4*)(Wq + (size_t)(npb + row) * 1024 + 128 * wid + 16 * ch) = *(const LAS u32x4*)(scr + row * 144 + ch * 16); }
    __syncthreads();
}
__device__ __forceinline__ void phase_p0(const Params& p, char* ws) {
    int tidx = threadIdx.x; asm volatile("" : "+v"(tidx));
    const int wid = __builtin_amdgcn_readfirstlane(tidx >> 6), lane = tidx & 63;
    LAS float* scr = (LAS float*)((LAS char*)dyn_lds + 1024 + wid * 16384);
    const int gw = (int)blockIdx.x * 8 + wid, NGW = (int)gridDim.x * 8;
    bf16_t* Win = (bf16_t*)(ws + WS_WIN); bf16_t* PA = (bf16_t*)(ws + WS_PA); bf16_t* PB = (bf16_t*)(ws + WS_PB); bf16_t* Wout = (bf16_t*)(ws + WS_WOUT);
    bf16_t* W1 = (bf16_t*)(ws + WS_W1); bf16_t* W2 = (bf16_t*)(ws + WS_W2);
    signed char* Winq = (signed char*)(ws + WS_WIN); float* swin = (float*)(ws + WS_SWIN);
    LAS float* xch = (LAS float*)((LAS char*)dyn_lds + 1024 + 8 * 16384);
    constexpr int B_W1 = NE * 64, B_W2 = NE * 32, B_IN = 96, B_G = 64, NBLK = B_W1 + B_W2 + B_IN + B_G;
    for (int bk = (int)blockIdx.x; bk < NBLK; bk += (int)gridDim.x) {
        int r = bk;
        if (r < B_W1) { const int e = r >> 6; p0_quant_block<0>(p.w1 + (size_t)e * 1024 * 2048, 2048, (signed char*)W1 + (size_t)e * 2048 * 1024, (float*)(ws + WS_SW1) + e * 2048, 1, 32 * (r & 63), (LAS char*)scr, xch, wid, lane); continue; } r -= B_W1;
        if (r < B_W2) { const int e = r >> 5; p0_quant_block<1>(p.w2 + (size_t)e * 1024 * 1024, 1024, (signed char*)W2 + (size_t)e * 1024 * 1024, (float*)(ws + WS_SW2) + e * 1024, 0, 32 * (r & 31), (LAS char*)scr, xch, wid, lane); continue; } r -= B_W2;
        if (r < B_IN) { const int n0 = 32 * r;
            p0_quant_block<0>(p.w_in, 3072, Winq, swin, 0, n0, (LAS char*)scr, xch, wid, lane, (n0 < 512 || (n0 >= 1536 && n0 < 2048)) ? C2LOG : 1.0f); continue; } r -= B_IN;
        p0_quant_block<0>(p.w_gate, 2048, Winq + (size_t)3072 * 1024, swin + 3072, 0, 32 * r, (LAS char*)scr, xch, wid, lane);
    }
    constexpr int I_P = 8 * 32, I_O = 16 * 32, NITEMS = 2 * I_P + I_O;
    for (int it = gw; it < NITEMS; it += NGW) {
        int r = it;
        if (r < I_P) { p0_transpose_item(p.w_proj_a, 512, 1024, PA, 1024, scr, r, lane); continue; } r -= I_P;
        if (r < I_P) { p0_transpose_item(p.w_proj_b, 512, 1024, PA + 512, 1024, scr, r, lane); continue; } r -= I_P;
        p0_transpose_item(p.w_out, 1024, 1024, Wout, 1024, scr, r, lane);
    }
    { int* stok_ = (int*)(ws + WS_STOK); int* rdst_ = (int*)(ws + WS_RDST); float* rss_ = (float*)(ws + WS_RSS); unsigned* amax_ = (unsigned*)(ws + WS_AMAX);
      for (int i = (int)blockIdx.x * 512 + tidx; i < MAXROWS; i += (int)gridDim.x * 512) { stok_[i] = -1; rdst_[i] = -1; rss_[i] = 0.f; }
      for (int i = (int)blockIdx.x * 512 + tidx; i < NTOK; i += (int)gridDim.x * 512) amax_[i] = 0u; }
    float* rope = (float*)(ws + WS_ROPE);
    for (int i = (int)blockIdx.x * 512 + tidx; i < SEQ * 8; i += (int)gridDim.x * 512) { const int pos = i >> 3, j = i & 7;
        const float fj = j == 0 ? p.fr.f[0] : j == 1 ? p.fr.f[1] : j == 2 ? p.fr.f[2] : j == 3 ? p.fr.f[3] : j == 4 ? p.fr.f[4] : j == 5 ? p.fr.f[5] : j == 6 ? p.fr.f[6] : p.fr.f[7];
        float sn, cs; sincosf((float)pos * fj, &sn, &cs); rope[i] = cs; rope[SEQ * 8 + i] = sn; }
    signed char* XNq = (signed char*)(ws + WS_XN); float* sx = (float*)(ws + WS_SX);
    for (int row0 = gw; row0 < NTOK; row0 += 2 * NGW) {
        f32x4 v[2][4];
#pragma unroll
        for (int q = 0; q < 2; ++q) { const f32x4* xr = (const f32x4*)(p.x + (size_t)(row0 + q * NGW) * DM) + lane;
#pragma unroll
            for (int i = 0; i < 4; ++i) v[q][i] = xr[64 * i]; }
#pragma unroll
        for (int q = 0; q < 2; ++q) { const int row = row0 + q * NGW; float ss = 0.f;
#pragma unroll
            for (int i = 0; i < 4; ++i) ss += (v[q][i][0] * v[q][i][0] + v[q][i][1] * v[q][i][1]) + (v[q][i][2] * v[q][i][2] + v[q][i][3] * v[q][i][3]);
            ss = wave_sum(ss); const float rn = rsqrtf(ss * (1.0f / DM) + 1e-5f); float am = 0.f;
#pragma unroll
            for (int i = 0; i < 4; ++i) { const f32x4 gg = ((const f32x4*)p.norm1_g)[lane + 64 * i]; v[q][i] = v[q][i] * rn * gg;
                am = __builtin_fmaxf(am, __builtin_fmaxf(__builtin_fmaxf(__builtin_fabsf(v[q][i][0]), __builtin_fabsf(v[q][i][1])), __builtin_fmaxf(__builtin_fabsf(v[q][i][2]), __builtin_fabsf(v[q][i][3])))); }
            am = wave_max(am); const float qs = am > 0.f ? 127.0f / am : 0.f;
            if (lane == 0) sx[row] = am * (1.0f / 127.0f);
#pragma unroll
            for (int i = 0; i < 4; ++i) { const unsigned w = pack4_i8(v[q][i], qs);
                *(unsigned*)(XNq + (size_t)row * DM + 4 * (lane + 64 * i)) = w; } }
    }
}
constexpr int RT_PITCH = 2064;
constexpr int RT_WG = 1024, RT_WM = RT_WG + 32 * RT_PITCH, RT_G2 = RT_WM + 32 * RT_PITCH, RT_HIST = RT_G2 + 4096;
__device__ __forceinline__ bool rt_better(float av, int ai, float bv, int bi) { return av > bv || (av == bv && ai < bi); }
__device__ __forceinline__ void phase_router(const bf16_t* __restrict__ x1, const float* __restrict__ g2, const float* __restrict__ wr, const float* __restrict__ br,
                                             signed char* __restrict__ h2, const unsigned* __restrict__ amax, int* __restrict__ toke, float* __restrict__ tokg, float* __restrict__ rnorm, int* __restrict__ cnt) {
    int tidx = threadIdx.x; asm volatile("" : "+v"(tidx));
    const int wid = __builtin_amdgcn_readfirstlane(tidx >> 6), lane = tidx & 63, r32 = lane & 31, hi = lane >> 5;
    LAS char* Wh = (LAS char*)dyn_lds + RT_WG; LAS char* Wm = (LAS char*)dyn_lds + RT_WM; LAS float* G2 = (LAS float*)((LAS char*)dyn_lds + RT_G2); LAS int* hist = (LAS int*)((LAS char*)dyn_lds + RT_HIST);
    for (int it = tidx; it < 4096; it += 512) { const int e = it & 31, kb = it >> 5; u32x4 ph, pm;
#pragma unroll
        for (int j = 0; j < 4; ++j) { const int k = 8 * kb + 2 * j; const float w0 = wr[k * 32 + e] * g2[k], w1 = wr[(k + 1) * 32 + e] * g2[k + 1];
            const unsigned h = cvtpk(w0, w1); const float r0 = w0 - bf2f(h & 0xffff), r1 = w1 - bf2f(h >> 16); ph[j] = h; pm[j] = cvtpk(r0, r1); }
        *(LAS u32x4*)(Wh + e * RT_PITCH + kb * 16) = ph; *(LAS u32x4*)(Wm + e * RT_PITCH + kb * 16) = pm; }
    for (int i = tidx; i < 1024; i += 512) G2[i] = g2[i];
    if (tidx < 32) hist[tidx] = 0;
    __syncthreads();
    for (int wt = (int)blockIdx.x * 8 + wid; wt < NTOK / 32; wt += (int)gridDim.x * 8) {
        const int tok = wt * 32 + r32;
        const bf16_t* xr = x1 + (size_t)tok * DM + 8 * hi; signed char* hr = h2 + (size_t)tok * DM + 8 * hi;
        const float am = __uint_as_float(amax[tok]), qs = am > 0.f ? 127.0f / am : 0.f;
        f32x16 acc;
#pragma unroll
        for (int r = 0; r < 16; ++r) acc[r] = 0.f;
        float ss = 0.f;
        u32x4 xw[2][8];
#pragma unroll
        for (int j = 0; j < 8; ++j) xw[0][j] = *(const u32x4*)(xr + 16 * j);
#pragma unroll
        for (int c = 0; c < 8; ++c) {
            if (c + 1 < 8) {
#pragma unroll
                for (int j = 0; j < 8; ++j) xw[(c + 1) & 1][j] = *(const u32x4*)(xr + 16 * (8 * (c + 1) + j)); }
            __builtin_amdgcn_sched_barrier(0);
#pragma unroll
            for (int j = 0; j < 8; ++j) { const int q = 8 * c + j;
                f32x4 xa, xb; pg8::unpack8(xw[c & 1][j], xa, xb);
                const f32x4 ga = *(const LAS f32x4*)(G2 + 16 * q + 8 * hi), gb = *(const LAS f32x4*)(G2 + 16 * q + 8 * hi + 4);
                ss += (xa[0] * xa[0] + xa[1] * xa[1]) + (xa[2] * xa[2] + xa[3] * xa[3]) + (xb[0] * xb[0] + xb[1] * xb[1]) + (xb[2] * xb[2] + xb[3] * xb[3]);
                const f32x4 ha = xa * ga, hb = xb * gb;
                u32x2 w;
                w.x = pack4_i8(ha, qs); w.y = pack4_i8(hb, qs);
                *(u32x2*)(hr + 16 * q) = w;
                const bf16x8 xf = __builtin_bit_cast(bf16x8, xw[c & 1][j]);
                const bf16x8 wh = *(const LAS bf16x8*)(Wh + r32 * RT_PITCH + (16 * q + 8 * hi) * 2), wm = *(const LAS bf16x8*)(Wm + r32 * RT_PITCH + (16 * q + 8 * hi) * 2);
                acc = MFMA32(wh, xf, acc); acc = MFMA32(wm, xf, acc);
            }
            __builtin_amdgcn_sched_barrier(0);
        }
        ss += __shfl_xor(ss, 32);
        const float rn = rsqrtf(ss * (1.0f / DM) + 1e-5f);
        float lg[16];
#pragma unroll
        for (int r = 0; r < 16; ++r) lg[r] = acc[r] * rn + br[crow(r, hi)];
        float tv[4]; int te[4];
#pragma unroll
        for (int k = 0; k < 4; ++k) { float bv = -INFINITY; int bi = 64;
#pragma unroll
            for (int r = 0; r < 16; ++r) { const int e = crow(r, hi); if (rt_better(lg[r], e, bv, bi)) { bv = lg[r]; bi = e; } }
            tv[k] = bv; te[k] = bi;
#pragma unroll
            for (int r = 0; r < 16; ++r) if (crow(r, hi) == bi) lg[r] = -INFINITY; }
        float pv[4]; int pe[4];
#pragma unroll
        for (int k = 0; k < 4; ++k) { pv[k] = __shfl_xor(tv[k], 32); pe[k] = __shfl_xor(te[k], 32); }
        float cv[8] = {tv[0], tv[1], tv[2], tv[3], pv[0], pv[1], pv[2], pv[3]}; int ce[8] = {te[0], te[1], te[2], te[3], pe[0], pe[1], pe[2], pe[3]};
        float fv[4]; int fe[4];
#pragma unroll
        for (int k = 0; k < 4; ++k) { float bv = -INFINITY; int bi = 64;
#pragma unroll
            for (int j = 0; j < 8; ++j) if (rt_better(cv[j], ce[j], bv, bi)) { bv = cv[j]; bi = ce[j]; }
            fv[k] = bv; fe[k] = bi;
#pragma unroll
            for (int j = 0; j < 8; ++j) if (ce[j] == bi) cv[j] = -INFINITY; }
        if (hi == 0) {
            const float e1 = __expf(fv[1] - fv[0]), e2 = __expf(fv[2] - fv[0]), e3 = __expf(fv[3] - fv[0]), inv = 1.0f / (1.0f + e1 + e2 + e3);
            *(int4*)(toke + (size_t)tok * 4) = make_int4(fe[0], fe[1], fe[2], fe[3]); *(float4*)(tokg + (size_t)tok * 4) = make_float4(inv, e1 * inv, e2 * inv, e3 * inv);
            rnorm[tok] = rn * am * (1.0f / 127.0f);
#pragma unroll
            for (int k = 0; k < 4; ++k) (void)__hip_atomic_fetch_add(hist + fe[k], 1, __ATOMIC_RELAXED, __HIP_MEMORY_SCOPE_WORKGROUP);
        }
    }
    __syncthreads();
    if (tidx < 32) atomicAdd(cnt + tidx, (int)hist[tidx]);
}
__device__ __forceinline__ void phase_assign(const int* __restrict__ toke, const float* __restrict__ tokg, const float* __restrict__ rnorm, int* ctrl, int* stok, int* rdst, float* rgate, float* rss) {
    int tidx = threadIdx.x; asm volatile("" : "+v"(tidx));
    LAS int* lcnt = (LAS int*)((LAS char*)dyn_lds + 1024); LAS int* lbase = lcnt + 32; LAS int* lps = lcnt + 64;
    if (tidx < 32) lcnt[tidx] = 0;
    if (tidx == 0) { int ps = 0; for (int e = 0; e < NE; ++e) { lps[e] = ps; ps += ((ctrl[C_CNT + e] + 255) >> 8) << 8; } lps[NE] = ps; }
    __syncthreads();
    if (blockIdx.x == 0) {
        const int ntl = lps[NE] >> 8;
        for (int t = tidx; t < ntl; t += 512) { int e = 0;
#pragma unroll 1
            for (int j = 1; j < NE; ++j) if (lps[j] <= t * 256) e = j;
            ctrl[C_TILEE + t] = e; }
        if (tidx == 0) ctrl[C_NTILES] = ntl;
    }
    for (int base = (int)blockIdx.x * 1024; base < NSLOT; base += (int)gridDim.x * 1024) {
        const int i0 = base + tidx, i1 = base + 512 + tidx;
        const int e0 = toke[i0], e1 = toke[i1];
        const int r0 = __hip_atomic_fetch_add(lcnt + e0, 1, __ATOMIC_RELAXED, __HIP_MEMORY_SCOPE_WORKGROUP), r1 = __hip_atomic_fetch_add(lcnt + e1, 1, __ATOMIC_RELAXED, __HIP_MEMORY_SCOPE_WORKGROUP);
        __syncthreads();
        if (tidx < 32) { const int c = lcnt[tidx]; lbase[tidx] = c ? atomicAdd(ctrl + C_FILL + tidx, c) : 0; }
        __syncthreads();
        const int row0 = lps[e0] + lbase[e0] + r0, row1 = lps[e1] + lbase[e1] + r1;
        stok[row0] = i0 >> 2; rdst[row0] = i0; rgate[row0] = tokg[i0]; rss[row0] = rnorm[i0 >> 2];
        stok[row1] = i1 >> 2; rdst[row1] = i1; rgate[row1] = tokg[i1]; rss[row1] = rnorm[i1 >> 2];
        __syncthreads();
        if (tidx < 32) lcnt[tidx] = 0;
        __syncthreads();
    }
}

__device__ __forceinline__ void phase_final(float* __restrict__ xo, const bf16_t* __restrict__ x1, const unsigned char* __restrict__ y, const float* __restrict__ gf) {
    typedef float f32x2_ __attribute__((ext_vector_type(2)));
    int tidx = threadIdx.x; asm volatile("" : "+v"(tidx));
    const int wid = __builtin_amdgcn_readfirstlane(tidx >> 6), lane = tidx & 63;
    for (int row = (int)blockIdx.x * 8 + wid; row < NTOK; row += (int)gridDim.x * 8) {
        float* xr = xo + (size_t)row * DM + 8 * lane; const bf16_t* x1r = x1 + (size_t)row * DM + 8 * lane; const unsigned char* yr = y + (size_t)row * 4 * DM + 8 * lane;
        f32x4 v[4]; u32x2 yw[4][2]; u32x4 xw[2];
#pragma unroll
        for (int hf = 0; hf < 2; ++hf) { xw[hf] = *(const u32x4*)(x1r + 512 * hf);
#pragma unroll
            for (int k = 0; k < 4; ++k) yw[k][hf] = *(const u32x2*)(yr + (size_t)k * DM + 512 * hf); }
        float ss = 0.f;
#pragma unroll
        for (int hf = 0; hf < 2; ++hf) { pg8::unpack8(xw[hf], v[2 * hf], v[2 * hf + 1]);
#pragma unroll
            for (int k = 0; k < 4; ++k) { const f32x2_ a = __builtin_amdgcn_cvt_pk_f32_fp8(yw[k][hf].x, false), b = __builtin_amdgcn_cvt_pk_f32_fp8(yw[k][hf].x, true), c = __builtin_amdgcn_cvt_pk_f32_fp8(yw[k][hf].y, false), d = __builtin_amdgcn_cvt_pk_f32_fp8(yw[k][hf].y, true);
                v[2 * hf][0] += a[0] * 0.125f; v[2 * hf][1] += a[1] * 0.125f; v[2 * hf][2] += b[0] * 0.125f; v[2 * hf][3] += b[1] * 0.125f;
                v[2 * hf + 1][0] += c[0] * 0.125f; v[2 * hf + 1][1] += c[1] * 0.125f; v[2 * hf + 1][2] += d[0] * 0.125f; v[2 * hf + 1][3] += d[1] * 0.125f; } }
#pragma unroll
        for (int i = 0; i < 4; ++i) ss += (v[i][0] * v[i][0] + v[i][1] * v[i][1]) + (v[i][2] * v[i][2] + v[i][3] * v[i][3]);
        ss = wave_sum(ss); const float r = rsqrtf(ss * (1.0f / DM) + 1e-5f);
#pragma unroll
        for (int hf = 0; hf < 2; ++hf) { const f32x4 g0 = *(const f32x4*)(gf + 8 * lane + 512 * hf), g1 = *(const f32x4*)(gf + 8 * lane + 512 * hf + 4);
            *(f32x4*)(xr + 512 * hf) = v[2 * hf] * r * g0; *(f32x4*)(xr + 512 * hf + 4) = v[2 * hf + 1] * r * g1; }
    }
}


#ifndef RPT_P0
#define RPT_P0 1
#endif
#ifndef RPT_INPROJ
#define RPT_INPROJ 1
#endif
#ifndef RPT_MIXA
#define RPT_MIXA 1
#endif
#ifndef RPT_MIXB
#define RPT_MIXB 1
#endif
#ifndef RPT_P3
#define RPT_P3 1
#endif
#ifndef RPT_MOE
#define RPT_MOE 1
#endif
#ifndef PHASE_MASK
#define PHASE_MASK 0xFF
#endif
constexpr int LDS_BYTES = 163840;
#define PHASE_LOOP(NX, NY, NZ, CALL) do { int tid = (int)(threadIdx.x & 255), half = (int)(threadIdx.x >> 8); asm volatile("" : "+v"(tid), "+v"(half)); for (int vb_ = (int)blockIdx.x * 2 + half; vb_ < (NX) * (NY) * (NZ); vb_ += (int)gridDim.x * 2) { \
    const int vbx = vb_ % (NX), vby = (vb_ / (NX)) % (NY), vbz = vb_ / ((NX) * (NY)); (void)vbx; (void)vby; (void)vbz; CALL; } } while (0)

__global__ __launch_bounds__(512, 2) void mega(Params p) {
    volatile LAS unsigned* xbw = (volatile LAS unsigned*)dyn_lds;
    if (threadIdx.x == 0) { xbw[0] = 0u; xbw[1] = 0u; xbw[2] = 0u; xbw[3] = 0u; }
    __syncthreads();
    char* ws = p.ws; float* out = p.out;
    XcdBarrier bar = xcd_barrier_post((unsigned*)(ws + WS_BAR), xbw);
    int* ctrl = (int*)(ws + WS_CTRL); float* rope = (float*)(ws + WS_ROPE);
    int* toke = (int*)(ws + WS_TOKE); float* tokg = (float*)(ws + WS_TOKG); int* stok = (int*)(ws + WS_STOK); int* rdst = (int*)(ws + WS_RDST); float* rgate = (float*)(ws + WS_RGATE);
    bf16_t* Win = (bf16_t*)(ws + WS_WIN); bf16_t* PA = (bf16_t*)(ws + WS_PA); bf16_t* PB = (bf16_t*)(ws + WS_PB); bf16_t* Wout = (bf16_t*)(ws + WS_WOUT);
    bf16_t* W1 = (bf16_t*)(ws + WS_W1); bf16_t* W2 = (bf16_t*)(ws + WS_W2);
    bf16_t* XN = (bf16_t*)(ws + WS_XN); bf16_t* OAB = (bf16_t*)(ws + WS_OAB); bf16_t* PROJ = (bf16_t*)(ws + WS_PROJ); bf16_t* MERGED = (bf16_t*)(ws + WS_MERGED);
    bf16_t* GATE = (bf16_t*)(ws + WS_GATE); bf16_t* H2 = (bf16_t*)(ws + WS_H2); bf16_t* ACT = (bf16_t*)(ws + WS_ACT); bf16_t* Y = (bf16_t*)(ws + WS_Y);
    for (int rp_ = 0; rp_ < RPT_P0; ++rp_) phase_p0(p, ws);
    xcd_barrier(bar);
    PG8_LAS unsigned char* ring = (PG8_LAS unsigned char*)dyn_lds + 1024;
    const int G = (int)gridDim.x, vcu = (G % 8 == 0) ? ((int)blockIdx.x % 8) * (G / 8) + (int)blockIdx.x / 8 : (int)blockIdx.x;
    for (int rp_ = 0; rp_ < RPT_INPROJ; ++rp_) { pg8::Gemm g{ws + WS_XN, ws + WS_WIN, nullptr, DM, DM, 0}; pg8::StaticOrder S; S.init(NTOK, 5120, G, (int)blockIdx.x);
      pg8::EpiInProjI e{pg8::EpiInProjF{PROJ, GATE, p.b_gate, rope}, (const float*)(ws + WS_SX), (const float*)(ws + WS_SWIN)};
      pg8::gemm_phase<pg8::EpiInProjI, pg8::StaticOrder, false, true, 1>(ring, g, S, e); }
    xcd_barrier(bar);
#ifdef GOLD_A
    if (PHASE_MASK & 4) PHASE_LOOP(NTOK * 8 / 4, 1, 1, b_attn_a_ref(vbx, vby, vbz, tid, PROJ, OAB));
#else
    for (int rp_ = 0; rp_ < RPT_MIXA; ++rp_) phase_mix_a(PROJ, OAB, rp_ + 1 < RPT_MIXA ? ABL_A : 0);
#endif
#ifdef GOLD_B
    if (PHASE_MASK & 8) PHASE_LOOP(NTOK * 8 / 4, 1, 1, b_attn_b_ref(vbx, vby, vbz, tid, PROJ, OAB));
#else
    for (int rp_ = 0; rp_ < RPT_MIXB; ++rp_) phase_mix_b(PROJ, OAB);
#endif
    xcd_barrier(bar);
    for (int rp_ = 0; rp_ < RPT_P3; ++rp_) { pg8::StaticOrder S; S.init(2 * NTOK, DM, G, (int)blockIdx.x);
      pg8::Gemm g{OAB, PA, nullptr, DM * 2, DM * 2, 0}; pg8::EpiProj2 e{(const unsigned char*)GATE, MERGED}; pg8::gemm_phase<pg8::EpiProj2, pg8::StaticOrder, false, true, 0, true>(ring, g, S, e); }
    xcd_barrier(bar);
    { pg8::Gemm g{MERGED, Wout, nullptr, DM * 2, DM * 2, 0}; pg8::StaticOrder S; S.init(NTOK, DM, G, (int)blockIdx.x); pg8::EpiWoutF e{p.x, (bf16_t*)(ws + WS_X1), p.norm2_g, (unsigned*)(ws + WS_AMAX)};
      pg8::gemm_phase<pg8::EpiWoutF, pg8::StaticOrder, false, true>(ring, g, S, e); }
    xcd_barrier(bar);
    float* rnorm = (float*)(ws + WS_RNORM);
    phase_router((const bf16_t*)(ws + WS_X1), p.norm2_g, p.w_router, p.b_router, (signed char*)H2, (const unsigned*)(ws + WS_AMAX), toke, tokg, rnorm, ctrl + C_CNT);
    xcd_barrier(bar);
    phase_assign(toke, tokg, rnorm, ctrl, stok, rdst, rgate, (float*)(ws + WS_RSS));
    xcd_barrier(bar);
    const int ntl = ctrl[C_NTILES];
#pragma unroll 1
    for (int ps_ = 0; ps_ < NPASS * RPT_MOE; ++ps_) { const int ps = ps_ % NPASS;
        const int t0 = ps * PASS_TILES; int T = ntl - t0; T = T < 0 ? 0 : (T > PASS_TILES ? PASS_TILES : T);
        if (T == 0) continue;
        { pg8::Gemm g{H2, W1, stok, DM, DM, 2048}; pg8::MoeOrder S{t0, T, 8, G, vcu, ctrl + C_TILEE}; pg8::EpiMoe1I e{ACT, p.b1, (const float*)(ws + WS_RSS), (const float*)(ws + WS_SW1), t0, 0};
          pg8::gemm_phase<pg8::EpiMoe1I, pg8::MoeOrder, true, true, 1>(ring, g, S, e); }
        xcd_barrier(bar);
        { pg8::Gemm g{(const unsigned char*)ACT - (size_t)t0 * 256 * DM, W2, nullptr, DM, DM, 1024}; pg8::MoeOrder S{t0, T, 4, G, vcu, ctrl + C_TILEE}; pg8::EpiMoe2F e{Y, p.b2, rdst, rgate, (const float*)(ws + WS_SW2)};
          pg8::gemm_phase<pg8::EpiMoe2F, pg8::MoeOrder, false, true, 2>(ring, g, S, e); }
        xcd_barrier(bar);
    }
    phase_final(out, (const bf16_t*)(ws + WS_X1), (const unsigned char*)Y, p.norm_f_g);
}

extern "C" void kernel_launch(void* const* d_in, const int* in_sizes, int n_in, void* d_out, int out_size, void* d_ws, size_t ws_size, hipStream_t stream) {
    if (ws_size < WS_NEED) { fprintf(stderr, "workspace too small: %zu < %zu\n", ws_size, (size_t)WS_NEED); return; }
    static int grid = 0;
    if (!grid) {
        int dev = 0, cus = 0, per_cu = 0; (void)hipGetDevice(&dev); (void)hipDeviceGetAttribute(&cus, hipDeviceAttributeMultiprocessorCount, dev);
        (void)hipFuncSetAttribute((const void*)mega, hipFuncAttributeMaxDynamicSharedMemorySize, LDS_BYTES);
        (void)hipOccupancyMaxActiveBlocksPerMultiprocessor(&per_cu, (const void*)mega, 512, LDS_BYTES);
        if (per_cu < 1) { fprintf(stderr, "mega: occupancy query says %d blocks per CU\n", per_cu); per_cu = 1; }
        grid = cus;
    }
    char* ws = (char*)d_ws;
    (void)hipMemsetAsync(ws, 0, 128 * 1024, stream);
    Params p{};
    p.x = (const float*)d_in[0]; p.norm1_g = (const float*)d_in[1]; p.w_in = (const float*)d_in[2]; p.w_proj_a = (const float*)d_in[3]; p.w_proj_b = (const float*)d_in[4];
    p.w_gate = (const float*)d_in[5]; p.b_gate = (const float*)d_in[6]; p.w_out = (const float*)d_in[7]; p.norm2_g = (const float*)d_in[8]; p.w_router = (const float*)d_in[9];
    p.b_router = (const float*)d_in[10]; p.w1 = (const float*)d_in[11]; p.b1 = (const float*)d_in[12]; p.w2 = (const float*)d_in[13]; p.b2 = (const float*)d_in[14]; p.norm_f_g = (const float*)d_in[15];
    p.out = (float*)d_out; p.ws = ws;
    for (int j = 0; j < 8; ++j) p.fr.f[j] = (float)pow(500000.0, -(double)j / 8.0);
    hipLaunchKernelGGL(mega, dim3(grid), dim3(512), LDS_BYTES, stream, p);
}
```

```cpp
#include <hip/hip_runtime.h>
#include <stdint.h>
#include <stdio.h>

#ifndef ABL_A
#define ABL_A 0
#endif
typedef unsigned short bf16_t;
typedef short bf16x8 __attribute__((ext_vector_type(8)));
typedef float f32x4 __attribute__((ext_vector_type(4)));
typedef unsigned u32x2 __attribute__((ext_vector_type(2)));
typedef unsigned u32x4 __attribute__((ext_vector_type(4)));

constexpr int NTOK = 65536, SEQ = 4096, DM = 1024, NE = 32, TOPK = 4;
constexpr int PROJ_NC = 3072, PROJ_LD = 3136, GATE_LD = 2048;
constexpr int NSLOT = NTOK * TOPK;
constexpr int MAXROWS = NSLOT + NE * 256;
constexpr int MAXTILES = MAXROWS / 256;
constexpr int PASS_TILES = 1056;
constexpr int NPASS = 1;

constexpr size_t MiB = 1ull << 20;
constexpr size_t WS_CTRL   = 0;
constexpr size_t WS_BAR    = 64 * 1024;
constexpr size_t WS_ROPE   = 128 * 1024;
constexpr size_t WS_TOKE   = 1 * MiB;
constexpr size_t WS_TOKG   = 2 * MiB;
constexpr size_t WS_STOK   = 3 * MiB;
constexpr size_t WS_RDST   = 5 * MiB;
constexpr size_t WS_RGATE  = 7 * MiB;
constexpr size_t WS_RNORM  = 8 * MiB + 512 * 1024;
constexpr size_t WS_AMAX   = 8 * MiB + 768 * 1024;
constexpr size_t WS_SX     = 14 * MiB;
constexpr size_t WS_SWIN   = 15 * MiB;
constexpr size_t WS_SW1    = 16 * MiB;
constexpr size_t WS_SW2    = 16 * MiB + 256 * 1024;
constexpr size_t WS_RSS    = 17 * MiB;
constexpr size_t WS_WIN    = 9 * MiB;
constexpr size_t WS_PA     = 19 * MiB;
constexpr size_t WS_PB     = 20 * MiB;
constexpr size_t WS_WOUT   = 21 * MiB;
constexpr size_t WS_W1     = 23 * MiB;
constexpr size_t WS_W2     = 151 * MiB;
constexpr size_t WS_R0     = 215 * MiB;
constexpr size_t WS_XN     = WS_R0;
constexpr size_t WS_OAB    = WS_R0;
constexpr size_t WS_PROJ   = WS_R0 + 128 * MiB;
constexpr size_t WS_MERGED = WS_PROJ;
constexpr size_t WS_GATE   = WS_R0 + 520 * MiB;
constexpr size_t WS_H2     = 87 * MiB;
constexpr size_t WS_ACT    = WS_R0;
constexpr size_t WS_Y      = WS_R0 + 264 * MiB;
constexpr size_t WS_X1     = WS_Y + 256 * MiB;
constexpr size_t WS_NEED   = WS_Y + 512 * MiB;

constexpr int C_CNT = 0;
constexpr int C_FILL = 64;
constexpr int C_PSTART = 128;
constexpr int C_NTILES = 192;
constexpr int C_TILEE = 256;

__device__ __forceinline__ bf16_t f2bf(float f) { unsigned u = __float_as_uint(f); u += 0x7FFFu + ((u >> 16) & 1u); return (bf16_t)(u >> 16); }
__device__ __forceinline__ float bf2f(bf16_t b) { return __uint_as_float((unsigned)b << 16); }
__device__ __forceinline__ unsigned pack2(float lo, float hi) { return (unsigned)f2bf(lo) | ((unsigned)f2bf(hi) << 16); }
__device__ __forceinline__ float wave_sum(float v) {
#pragma unroll
    for (int o = 32; o > 0; o >>= 1) v += __shfl_xor(v, o);
    return v; }
__device__ __forceinline__ float wave_max(float v) {
#pragma unroll
    for (int o = 32; o > 0; o >>= 1) v = fmaxf(v, __shfl_xor(v, o));
    return v; }
__device__ __forceinline__ float sigmoidf_(float x) { return __builtin_amdgcn_rcpf(1.0f + __builtin_amdgcn_exp2f(x * -1.4426950408889634f)); }


#define XB_TMO      128
#define XB_XCNT(j)  (256  + 64 * (j))
#define XB_XSUB(j)  (1280 + 64 * (j))
#define XB_XGEN(j)  (2304 + 64 * (j))
#define XB_TOP      3328
#define XB_TOPGEN   3392
#define XCD_BAR_WORDS 3456
#define XB_SPIN_CAP (1u << 22)
#define LAS __attribute__((address_space(3)))
__device__ __forceinline__ unsigned xb_ld(unsigned* p)              { return __hip_atomic_load(p, __ATOMIC_RELAXED, __HIP_MEMORY_SCOPE_AGENT); }
__device__ __forceinline__ unsigned xb_add(unsigned* p, unsigned v) { return __hip_atomic_fetch_add(p, v, __ATOMIC_RELAXED, __HIP_MEMORY_SCOPE_AGENT); }
__device__ __forceinline__ unsigned xb_xcc_id() { return (unsigned)__builtin_amdgcn_s_getreg((3 << 11) | 20) & 0xFu; }
#define XB_SPIN(cond, bar) do { unsigned _sp = 0; while (cond) { __builtin_amdgcn_s_sleep(1); \
    if ((++_sp & 255u) == 0u) { if (xb_ld(&(bar)[XB_TMO])) break; if (_sp > XB_SPIN_CAP) { atomicAdd(&(bar)[XB_TMO], 1u); break; } } } } while (0)
struct XcdBarrier { unsigned* bar; unsigned x; volatile LAS unsigned* st; };
__device__ __forceinline__ XcdBarrier xcd_barrier_post(unsigned* bar, volatile LAS unsigned* st) {
    XcdBarrier b; b.bar = bar; b.x = xb_xcc_id(); b.st = st;
    if (threadIdx.x == 0) (void)xb_add(&bar[XB_XCNT(b.x)], 1u);
    return b;
}
__device__ __forceinline__ void xcd_barrier_complete(unsigned* bar, unsigned x, unsigned& nloc, unsigned& nx) {
    const unsigned G = gridDim.x * gridDim.y * gridDim.z;
    unsigned sum, cnt, mine, sp = 0u;
    for (;;) {
        sum = 0u; cnt = 0u; mine = 0u;
#pragma unroll
        for (unsigned j = 0; j < 16; ++j) { const unsigned c = xb_ld(&bar[XB_XCNT(j)]); sum += c; cnt += (c > 0u) ? 1u : 0u; mine = (j == x) ? c : mine; }
        if (sum == G) break;
        __builtin_amdgcn_s_sleep(1);
        if ((++sp & 255u) == 0u) { if (xb_ld(&bar[XB_TMO])) break; if (sp > XB_SPIN_CAP) { atomicAdd(&bar[XB_TMO], 1u); break; } }
    }
    nloc = mine > 0u ? mine : 1u; nx = cnt > 0u ? cnt : 1u;
}
__device__ __forceinline__ void xcd_barrier(const XcdBarrier& b) {
    asm volatile("s_waitcnt vmcnt(0)" ::: "memory");
    __syncthreads();
    if (threadIdx.x == 0) {
        unsigned* bar = b.bar;
        __builtin_amdgcn_s_waitcnt(0);
        unsigned nloc = b.st[0], nx = b.st[1];
        if (nloc == 0u) { xcd_barrier_complete(bar, b.x, nloc, nx); b.st[0] = nloc; b.st[1] = nx; }
        const unsigned old = xb_add(&bar[XB_XSUB(b.x)], 1u);
        const unsigned gen = old / nloc;
        if (old + 1u == (gen + 1u) * nloc) {
            __builtin_amdgcn_fence(__ATOMIC_RELEASE, "agent");
            asm volatile("s_waitcnt vmcnt(0)" ::: "memory");
            const unsigned og = xb_add(&bar[XB_TOP], 1u);
            const unsigned tg = og / nx;
            if (og + 1u == (tg + 1u) * nx) xb_add(&bar[XB_TOPGEN], 1u);
            else XB_SPIN(xb_ld(&bar[XB_TOPGEN]) == tg, bar);
            __builtin_amdgcn_fence(__ATOMIC_ACQUIRE, "agent");
            xb_add(&bar[XB_XGEN(b.x)], 1u);
            asm volatile("s_waitcnt vmcnt(0)" ::: "memory");
        } else {
            XB_SPIN(xb_ld(&bar[XB_XGEN(b.x)]) == gen, bar);
            __builtin_amdgcn_fence(__ATOMIC_ACQUIRE, "agent");
            asm volatile("s_waitcnt vmcnt(0)" ::: "memory");
        }
    }
    __syncthreads();
}

__device__ __forceinline__ int w1map(int c) { const int half = c >> 10, cc = c & 1023; return (cc >> 7) * 256 + half * 128 + (cc & 127); }
template <int MODE>
__device__ __forceinline__ void b_cvt_t(const int vbx, const int vby, const int vbz, const int tid, float (*tile)[65], const float* __restrict__ src, bf16_t* __restrict__ dst, int K, int N) {
    const size_t boff = (size_t)vbz * K * N; src += boff; dst += boff;
    const int n0 = vbx * 64, k0 = vby * 64, tx = tid & 63, ty = tid >> 6;
    for (int i = ty; i < 64; i += 4) tile[i][tx] = src[(size_t)(k0 + i) * N + n0 + tx];
    __syncthreads();
    for (int i = ty; i < 64; i += 4) { const int n = n0 + i; const int np = (MODE == 1) ? w1map(n) : n; dst[(size_t)np * K + k0 + tx] = f2bf(tile[tx][i]); }
}

struct RopeF { float f[8]; };
__device__ __forceinline__ void b_rope_tab(const int vbx, const int vby, const int vbz, const int tid, float* tab, RopeF fr) {
    const int i = vbx * 256 + tid; if (i >= SEQ * 8) return;
    const int pos = i >> 3, j = i & 7;
    const float fj = j == 0 ? fr.f[0] : j == 1 ? fr.f[1] : j == 2 ? fr.f[2] : j == 3 ? fr.f[3] : j == 4 ? fr.f[4] : j == 5 ? fr.f[5] : j == 6 ? fr.f[6] : fr.f[7];
    const float ang = (float)pos * fj;
    float s, c; sincosf(ang, &s, &c); tab[i] = c; tab[SEQ * 8 + i] = s;
}

__device__ __forceinline__ void b_rmsnorm_bf16(const int vbx, const int vby, const int vbz, const int tid, const float* __restrict__ x, const float* __restrict__ g, bf16_t* __restrict__ out) {
    const int row = vbx * 4 + (tid >> 6), lane = tid & 63;
    const float4* xr = (const float4*)(x + (size_t)row * DM); float4 v[4]; float ss = 0.f;
#pragma unroll
    for (int i = 0; i < 4; ++i) { v[i] = xr[lane + 64 * i]; ss += v[i].x * v[i].x + v[i].y * v[i].y + v[i].z * v[i].z + v[i].w * v[i].w; }
    ss = wave_sum(ss); const float r = rsqrtf(ss * (1.0f / DM) + 1e-5f);
#pragma unroll
    for (int i = 0; i < 4; ++i) { const float4 gg = ((const float4*)g)[lane + 64 * i];
        u32x2 w; w.x = pack2(v[i].x * r * gg.x, v[i].y * r * gg.y); w.y = pack2(v[i].z * r * gg.z, v[i].w * r * gg.w);
        *(u32x2*)(out + (size_t)row * DM + 4 * (lane + 64 * i)) = w; }
}

struct GemmArgs {
    const bf16_t* A; const bf16_t* Bt;
    const int* rowidx;
    const int* tile_e;
    const int* ntiles;
    size_t b_estride; int lda, ldb, K, row_base;
};
template <class Epi, bool DUAL>
__device__ __forceinline__ void b_gemm_ref(const int vbx, const int vby, const int vbz, const int tid, GemmArgs g, Epi epi) {
    const int wid = tid >> 6, lane = tid & 63, wr = wid >> 1, wc = wid & 1, fr = lane & 15, fq = lane >> 4;
    const int m0 = vby * 128 + wr * 64, n0 = vbx * 128 + wc * 64;
    int e = 0;
    if (g.ntiles) { const int tile = (g.row_base + vby * 128) >> 8; if (tile >= *g.ntiles) return; e = g.tile_e[tile]; }
    const bf16_t* Bt = g.Bt + (size_t)e * g.b_estride;
    const bf16_t* ap[4]; const bf16_t* bp[4];
#pragma unroll
    for (int m = 0; m < 4; ++m) { int r = m0 + m * 16 + fr; if (g.rowidx) { r = g.rowidx[g.row_base + r]; if (r < 0) r = 0; } ap[m] = g.A + (size_t)r * g.lda + fq * 8; }
#pragma unroll
    for (int n = 0; n < 4; ++n) { int c = n0 + n * 16 + fr; if (DUAL) c = (c >> 7) * 256 + (c & 127); bp[n] = Bt + (size_t)c * g.ldb + fq * 8; }
    f32x4 acc[4][4], acc2[4][4];
#pragma unroll
    for (int m = 0; m < 4; ++m)
#pragma unroll
        for (int n = 0; n < 4; ++n) { acc[m][n] = (f32x4){0.f, 0.f, 0.f, 0.f}; acc2[m][n] = (f32x4){0.f, 0.f, 0.f, 0.f}; }
    for (int k0 = 0; k0 < g.K; k0 += 32) {
        bf16x8 a[4], b[4], b2[4];
#pragma unroll
        for (int m = 0; m < 4; ++m) a[m] = *(const bf16x8*)(ap[m] + k0);
#pragma unroll
        for (int n = 0; n < 4; ++n) { b[n] = *(const bf16x8*)(bp[n] + k0); if (DUAL) b2[n] = *(const bf16x8*)(bp[n] + (size_t)128 * g.ldb + k0); }
#pragma unroll
        for (int m = 0; m < 4; ++m)
#pragma unroll
            for (int n = 0; n < 4; ++n) { acc[m][n] = __builtin_amdgcn_mfma_f32_16x16x32_bf16(b[n], a[m], acc[m][n], 0, 0, 0);
                if (DUAL) acc2[m][n] = __builtin_amdgcn_mfma_f32_16x16x32_bf16(b2[n], a[m], acc2[m][n], 0, 0, 0); }
    }
#pragma unroll
    for (int m = 0; m < 4; ++m)
#pragma unroll
        for (int n = 0; n < 4; ++n) epi(m0 + m * 16 + fr, n0 + n * 16 + 4 * fq, acc[m][n], acc2[m][n], e);
}

struct EpiInProj {
    bf16_t* proj; bf16_t* gate; const float* bgate;
    __device__ void operator()(int row, int col, f32x4 v, f32x4, int) const {
        if (col < PROJ_NC) { u32x2 w; w.x = pack2(v[0], v[1]); w.y = pack2(v[2], v[3]); *(u32x2*)(proj + (size_t)row * PROJ_LD + col) = w; }
        else { const int c = col - PROJ_NC; const f32x4 b = *(const f32x4*)(bgate + c);
            u32x2 w; w.x = pack2(sigmoidf_(v[0] + b[0]), sigmoidf_(v[1] + b[1])); w.y = pack2(sigmoidf_(v[2] + b[2]), sigmoidf_(v[3] + b[3])); *(u32x2*)(gate + (size_t)row * GATE_LD + c) = w; }
    }
};
struct EpiProjA {
    float* tmp; const bf16_t* gate;
    __device__ void operator()(int row, int col, f32x4 v, f32x4, int) const {
        const u32x2 gw = *(const u32x2*)(gate + (size_t)row * GATE_LD + col);
        f32x4 o; o[0] = v[0] * bf2f(gw.x & 0xffff); o[1] = v[1] * bf2f(gw.x >> 16); o[2] = v[2] * bf2f(gw.y & 0xffff); o[3] = v[3] * bf2f(gw.y >> 16);
        *(f32x4*)(tmp + (size_t)row * DM + col) = o; }
};
struct EpiProjB {
    const float* tmp; const bf16_t* gate; bf16_t* merged;
    __device__ void operator()(int row, int col, f32x4 v, f32x4, int) const {
        const u32x2 gw = *(const u32x2*)(gate + (size_t)row * GATE_LD + DM + col); const f32x4 t = *(const f32x4*)(tmp + (size_t)row * DM + col);
        u32x2 w; w.x = pack2(t[0] + v[0] * bf2f(gw.x & 0xffff), t[1] + v[1] * bf2f(gw.x >> 16)); w.y = pack2(t[2] + v[2] * bf2f(gw.y & 0xffff), t[3] + v[3] * bf2f(gw.y >> 16));
        *(u32x2*)(merged + (size_t)row * DM + col) = w; }
};
struct EpiWout {
    const float* x; float* x1;
    __device__ void operator()(int row, int col, f32x4 v, f32x4, int) const {
        const f32x4 xx = *(const f32x4*)(x + (size_t)row * DM + col); *(f32x4*)(x1 + (size_t)row * DM + col) = xx + v; }
};
struct EpiMoe1 {
    bf16_t* act; const float* b1;
    __device__ void operator()(int row, int col, f32x4 v, f32x4 v2, int e) const {
        const f32x4 bg = *(const f32x4*)(b1 + (size_t)e * 2048 + col), bl = *(const f32x4*)(b1 + (size_t)e * 2048 + 1024 + col); float o[4];
#pragma unroll
        for (int i = 0; i < 4; ++i) { const float glu = fminf(v[i] + bg[i], 7.0f), lin = fminf(fmaxf(v2[i] + bl[i], -7.0f), 7.0f); o[i] = glu * sigmoidf_(1.702f * glu) * (lin + 1.0f); }
        u32x2 w; w.x = pack2(o[0], o[1]); w.y = pack2(o[2], o[3]); *(u32x2*)(act + (size_t)row * DM + col) = w; }
};
struct EpiMoe2 {
    bf16_t* y; const float* b2; const int* rdst; const float* rgate; int row_base; int pad_;
    __device__ void operator()(int row, int col, f32x4 v, f32x4, int e) const {
        const int dst = rdst[row_base + row]; if (dst < 0) return; const float gt = rgate[row_base + row]; const f32x4 b = *(const f32x4*)(b2 + (size_t)e * DM + col);
        u32x2 w; w.x = pack2(gt * (v[0] + b[0]), gt * (v[1] + b[1])); w.y = pack2(gt * (v[2] + b[2]), gt * (v[3] + b[3])); *(u32x2*)(y + (size_t)dst * DM + col) = w; }
};

__device__ __forceinline__ void b_rope(const int vbx, const int vby, const int vbz, const int tid, bf16_t* proj, const float* tab) {
    const int i = vbx * 256 + tid;
    const int j = i & 7, head = (i >> 3) & 7, qk = (i >> 6) & 1, tok = i >> 7; if (tok >= NTOK) return;
    bf16_t* p = proj + (size_t)tok * PROJ_LD + qk * 512 + head * 64; const int pos = tok & (SEQ - 1);
    const float c = tab[pos * 8 + j], s = tab[SEQ * 8 + pos * 8 + j], x1 = bf2f(p[j]), x2 = bf2f(p[j + 8]);
    p[j] = f2bf(x1 * c - x2 * s); p[j + 8] = f2bf(x2 * c + x1 * s);
}

__device__ __forceinline__ void load_row64(const bf16_t* p, float* q) {
#pragma unroll
    for (int c = 0; c < 8; ++c) { const u32x4 w = *(const u32x4*)(p + c * 8);
        q[c * 8 + 0] = bf2f(w.x & 0xffff); q[c * 8 + 1] = bf2f(w.x >> 16); q[c * 8 + 2] = bf2f(w.y & 0xffff); q[c * 8 + 3] = bf2f(w.y >> 16);
        q[c * 8 + 4] = bf2f(w.z & 0xffff); q[c * 8 + 5] = bf2f(w.z >> 16); q[c * 8 + 6] = bf2f(w.w & 0xffff); q[c * 8 + 7] = bf2f(w.w >> 16); }
}
__device__ __forceinline__ float dot_row64(const bf16_t* p, const float* q) {
    float s = 0.f;
#pragma unroll
    for (int c = 0; c < 8; ++c) { const u32x4 w = *(const u32x4*)(p + c * 8);
        s += q[c * 8 + 0] * bf2f(w.x & 0xffff) + q[c * 8 + 1] * bf2f(w.x >> 16) + q[c * 8 + 2] * bf2f(w.y & 0xffff) + q[c * 8 + 3] * bf2f(w.y >> 16)
           + q[c * 8 + 4] * bf2f(w.z & 0xffff) + q[c * 8 + 5] * bf2f(w.z >> 16) + q[c * 8 + 6] * bf2f(w.w & 0xffff) + q[c * 8 + 7] * bf2f(w.w >> 16); }
    return s;
}
__device__ __forceinline__ void b_attn_a_ref(const int vbx, const int vby, const int vbz, const int tid, const bf16_t* __restrict__ proj, bf16_t* __restrict__ oab) {
    const int wv = vbx * 4 + (tid >> 6), lane = tid & 63;
    const int t = wv & (SEQ - 1), h = (wv >> 12) & 7, b = wv >> 15;
    const bf16_t* base = proj + (size_t)b * SEQ * PROJ_LD + h * 64;
    float q[64]; load_row64(base + (size_t)t * PROJ_LD, q);
    float sc[7]; float mx = -INFINITY;
#pragma unroll
    for (int it = 0; it < 7; ++it) { const int i = it * 64 + lane; sc[it] = -INFINITY;
        if (i < 387) { const int gi = i / 129, j = i - gi * 129, dil = gi == 0 ? 1 : (gi == 1 ? 4 : 16), kp = t - j * dil;
            if (kp >= 0) sc[it] = dot_row64(base + 512 + (size_t)kp * PROJ_LD, q) * 0.125f; }
        mx = fmaxf(mx, sc[it]); }
    mx = wave_max(mx); float l = 0.f;
#pragma unroll
    for (int it = 0; it < 7; ++it) { sc[it] = (sc[it] == -INFINITY) ? 0.f : __expf(sc[it] - mx); l += sc[it]; }
    l = wave_sum(l); float o = 0.f;
#pragma unroll
    for (int it = 0; it < 7; ++it)
        for (int ln = 0; ln < 64; ++ln) { const int i = it * 64 + ln; if (i >= 387) break;
            const float p = __shfl(sc[it], ln); const int gi = i / 129, j = i - gi * 129, dil = gi == 0 ? 1 : (gi == 1 ? 4 : 16), kp = t - j * dil;
            if (kp >= 0) o += p * bf2f(base[1024 + (size_t)kp * PROJ_LD + lane]); }
    oab[((size_t)b * SEQ + t) * DM + h * 64 + lane] = f2bf(o / l);
}

__device__ __forceinline__ void b_attn_b_ref(const int vbx, const int vby, const int vbz, const int tid, const bf16_t* __restrict__ proj, bf16_t* __restrict__ oab) {
    const int wv = vbx * 4 + (tid >> 6), lane = tid & 63;
    const int t = wv & (SEQ - 1), h = (wv >> 12) & 7, b = wv >> 15;
    const bf16_t* base = proj + (size_t)b * SEQ * PROJ_LD + 1536 + h * 64;
    float q[64]; load_row64(base + (size_t)t * PROJ_LD, q);
    float carry = 0.f, o = 0.f;
    for (int shi = t - 1; shi >= 0; shi -= 64) {
        const int s = shi - lane; const bool valid = s >= 0; float z = 0.f;
        if (valid) z = dot_row64(base + 512 + (size_t)s * PROJ_LD, q) * 0.125f;
        const float sp = fmaxf(z, 0.f) + log1pf(__expf(-fabsf(z)));
        const float lk = valid ? -sp : 0.f;
        float incl = lk;
#pragma unroll
        for (int o2 = 1; o2 < 64; o2 <<= 1) { const float up = __shfl_up(incl, o2); if (lane >= o2) incl += up; }
        const float a = valid ? __expf(z - sp + carry + (incl - lk)) : 0.f;
        carry += __shfl(incl, 63);
        const int nk = (shi + 1) < 64 ? (shi + 1) : 64;
        for (int i = 0; i < nk; ++i) { const float ai = __shfl(a, i); o += ai * bf2f(base[1024 + (size_t)(shi - i) * PROJ_LD + lane]); }
    }
    oab[((size_t)b * SEQ + t) * DM + 512 + h * 64 + lane] = f2bf(o);
}

__device__ __forceinline__ void b_norm2_router(const int vbx, const int vby, const int vbz, const int tid, const float* __restrict__ x1, const float* __restrict__ g2, const float* __restrict__ wr, const float* __restrict__ br,
                                                      bf16_t* __restrict__ h2, int* __restrict__ toke, float* __restrict__ tokg, int* __restrict__ cnt) {
    const int row = vbx * 4 + (tid >> 6), lane = tid & 63;
    const float4* xr = (const float4*)(x1 + (size_t)row * DM); float4 v[4]; float ss = 0.f;
#pragma unroll
    for (int i = 0; i < 4; ++i) { v[i] = xr[lane + 64 * i]; ss += v[i].x * v[i].x + v[i].y * v[i].y + v[i].z * v[i].z + v[i].w * v[i].w; }
    ss = wave_sum(ss); const float r = rsqrtf(ss * (1.0f / DM) + 1e-5f);
    float lg[NE];
#pragma unroll
    for (int e = 0; e < NE; ++e) lg[e] = 0.f;
#pragma unroll 1
    for (int i = 0; i < 4; ++i) { const float4 xv = xr[lane + 64 * i]; const float4 gg = ((const float4*)g2)[lane + 64 * i]; const int c0 = 4 * (lane + 64 * i);
        const float h0 = xv.x * r * gg.x, h1 = xv.y * r * gg.y, h2v = xv.z * r * gg.z, h3 = xv.w * r * gg.w;
        u32x2 w; w.x = pack2(h0, h1); w.y = pack2(h2v, h3); *(u32x2*)(h2 + (size_t)row * DM + c0) = w;
#pragma unroll
        for (int jj = 0; jj < 4; ++jj) { const float4* wrow = (const float4*)(wr + (size_t)(c0 + jj) * NE); const float hv = jj == 0 ? h0 : (jj == 1 ? h1 : (jj == 2 ? h2v : h3));
#pragma unroll
            for (int e4 = 0; e4 < 8; ++e4) { const float4 ww = wrow[e4]; lg[e4 * 4 + 0] += hv * ww.x; lg[e4 * 4 + 1] += hv * ww.y; lg[e4 * 4 + 2] += hv * ww.z; lg[e4 * 4 + 3] += hv * ww.w; } } }
#pragma unroll
    for (int e = 0; e < NE; ++e) lg[e] = wave_sum(lg[e]) + br[e];
    int te[4]; float tv[4];
#pragma unroll
    for (int k = 0; k < 4; ++k) { float best = -INFINITY; int bi = 0;
#pragma unroll
        for (int e = 0; e < NE; ++e) { if (lg[e] > best) { best = lg[e]; bi = e; } }
        te[k] = bi; tv[k] = best;
#pragma unroll
        for (int e = 0; e < NE; ++e) if (e == bi) lg[e] = -INFINITY; }
    const float e1 = __expf(tv[1] - tv[0]), e2 = __expf(tv[2] - tv[0]), e3 = __expf(tv[3] - tv[0]), inv = 1.0f / (1.0f + e1 + e2 + e3);
    if (lane == 0) { *(int4*)(toke + (size_t)row * 4) = make_int4(te[0], te[1], te[2], te[3]); *(float4*)(tokg + (size_t)row * 4) = make_float4(inv, e1 * inv, e2 * inv, e3 * inv);
        atomicAdd(cnt + te[0], 1); atomicAdd(cnt + te[1], 1); atomicAdd(cnt + te[2], 1); atomicAdd(cnt + te[3], 1); }
}
__device__ __forceinline__ void b_scan(const int vbx, const int vby, const int vbz, const int tid, int* ctrl) {
    if (tid != 0 || vbx != 0) return;
    int ps = 0, tile = 0;
    for (int e = 0; e < NE; ++e) { ctrl[C_PSTART + e] = ps; const int nt = (ctrl[C_CNT + e] + 255) >> 8; for (int i = 0; i < nt; ++i) ctrl[C_TILEE + tile++] = e; ps += nt * 256; }
    ctrl[C_PSTART + NE] = ps; ctrl[C_NTILES] = tile;
}
__device__ __forceinline__ void b_assign(const int vbx, const int vby, const int vbz, const int tid, const int* __restrict__ toke, const float* __restrict__ tokg, int* ctrl, int* stok, int* rdst, float* rgate) {
    const int i = vbx * 256 + tid; if (i >= NSLOT) return;
    const int e = toke[i]; const int pos = atomicAdd(ctrl + C_FILL + e, 1); const int row = ctrl[C_PSTART + e] + pos;
    stok[row] = i >> 2; rdst[row] = i; rgate[row] = tokg[i];
}
__device__ __forceinline__ void b_final(const int vbx, const int vby, const int vbz, const int tid, float* __restrict__ xo, const bf16_t* __restrict__ y, const float* __restrict__ gf) {
    const int row = vbx * 4 + (tid >> 6), lane = tid & 63;
    float4* xr = (float4*)(xo + (size_t)row * DM); float4 v[4]; float ss = 0.f;
#pragma unroll
    for (int i = 0; i < 4; ++i) { v[i] = xr[lane + 64 * i];
#pragma unroll
        for (int k = 0; k < 4; ++k) { const u32x2 w = *(const u32x2*)(y + ((size_t)row * 4 + k) * DM + 4 * (lane + 64 * i));
            v[i].x += bf2f(w.x & 0xffff); v[i].y += bf2f(w.x >> 16); v[i].z += bf2f(w.y & 0xffff); v[i].w += bf2f(w.y >> 16); }
        ss += v[i].x * v[i].x + v[i].y * v[i].y + v[i].z * v[i].z + v[i].w * v[i].w; }
    ss = wave_sum(ss); const float r = rsqrtf(ss * (1.0f / DM) + 1e-5f);
#pragma unroll
    for (int i = 0; i < 4; ++i) { const float4 gg = ((const float4*)gf)[lane + 64 * i]; xr[lane + 64 * i] = make_float4(v[i].x * r * gg.x, v[i].y * r * gg.y, v[i].z * r * gg.z, v[i].w * r * gg.w); }
}


extern __shared__ __attribute__((aligned(16))) unsigned char dyn_lds[];

typedef float f32x16 __attribute__((ext_vector_type(16)));
typedef short s16x4 __attribute__((ext_vector_type(4)));
typedef short v4i16_t __attribute__((ext_vector_type(4)));
#define MFMA32(a, b, c) __builtin_amdgcn_mfma_f32_32x32x16_bf16(a, b, c, 0, 0, 0)
__device__ __forceinline__ int crow(int r, int hi) { return (r & 3) + 8 * (r >> 2) + 4 * hi; }
typedef __bf16 bf16x2_t __attribute__((ext_vector_type(2)));
typedef float f32x2_t __attribute__((ext_vector_type(2)));
__device__ __forceinline__ unsigned cvtpk(float lo, float hi) { const f32x2_t v = {lo, hi}; const bf16x2_t b = __builtin_convertvector(v, bf16x2_t); return __builtin_bit_cast(unsigned, b); }
__device__ __forceinline__ s16x4 vtr(const LAS char* p) { return __builtin_bit_cast(s16x4, __builtin_amdgcn_ds_read_tr16_b64_v4i16((LAS v4i16_t*)p)); }
#define WAVE_FENCE() asm volatile("" ::: "memory")
constexpr float C2LOG = 0.125f * 1.4426950408889634f;
constexpr int MIX_WAVE_LDS = 8448;
constexpr int MIX_LDS_BASE = 1024;
constexpr int MIX_STG = 4096, MIX_ASC = 8192;
constexpr int MIX_PARK = MIX_LDS_BASE + 8 * MIX_WAVE_LDS;
constexpr int MIX_PLSE = MIX_PARK + 512 * 128;

__device__ __forceinline__ void mix_load_k(bf16x8 (&kf)[4], const bf16_t* kbase, int lfirst, int dil, int rr, int r32, int hi) {
    int l = lfirst + r32; l = l < 0 ? 0 : l;
    const char* base = (const char*)(kbase + (size_t)rr * PROJ_LD); const unsigned off = (unsigned)(l * dil) * (unsigned)(PROJ_LD * 2) + (unsigned)hi * 16u;
#pragma unroll
    for (int d0 = 0; d0 < 4; ++d0) kf[d0] = *(const bf16x8*)(base + off + d0 * 32);
}
__device__ __forceinline__ void mix_load_v(u32x4 (&vr)[4], const bf16_t* vbase, int lfirst, int dil, int rr, int lane) {
    const char* base = (const char*)(vbase + (size_t)rr * PROJ_LD);
#pragma unroll
    for (int c = 0; c < 2; ++c) { int l = lfirst + c * 16 + (lane >> 2); l = l < 0 ? 0 : l;
        const unsigned off = (unsigned)(l * dil) * (unsigned)(PROJ_LD * 2) + (unsigned)(lane & 3) * 16u;
        vr[c] = *(const u32x4*)(base + off); vr[c + 2] = *(const u32x4*)(base + off + 64); }
}
__device__ __forceinline__ void mix_store_v(const u32x4 (&vr)[4], LAS char* slot, int lane) {
    WAVE_FENCE();
#pragma unroll
    for (int c = 0; c < 4; ++c) *(LAS u32x4*)(slot + c * 1024 + lane * 16) = vr[c];
    WAVE_FENCE();
}
__device__ __forceinline__ void mix_pv(f32x16& o0, f32x16& o1, const u32x4& pw0, const u32x4& pw1, const LAS char* slot, int lane) {
    const int hi = lane >> 5; const LAS char* vb = slot + (4 * hi + ((lane & 15) >> 2)) * 64 + ((lane >> 4) & 1) * 32 + (lane & 3) * 8;
    bf16x8 vf[4];
#pragma unroll
    for (int i = 0; i < 4; ++i) { const s16x4 lo = vtr(vb + (i >> 1) * 2048 + (i & 1) * 1024), hh = vtr(vb + (i >> 1) * 2048 + (i & 1) * 1024 + 512);
        vf[i] = (bf16x8){lo[0], lo[1], lo[2], lo[3], hh[0], hh[1], hh[2], hh[3]}; }
    __builtin_amdgcn_sched_barrier(0);
    const bf16x8 p0 = __builtin_bit_cast(bf16x8, pw0), p1 = __builtin_bit_cast(bf16x8, pw1);
    o0 = MFMA32(p0, vf[0], o0); o1 = MFMA32(p0, vf[2], o1); o0 = MFMA32(p1, vf[1], o0); o1 = MFMA32(p1, vf[3], o1);
}
__device__ __forceinline__ void mix_stage_o(const f32x16& o0, const f32x16& o1, LAS char* stg, int r32, int hi) {
    WAVE_FENCE();
#pragma unroll
    for (int r = 0; r < 16; ++r) { const int q = crow(r, hi);
        *(LAS bf16_t*)(stg + (q * 64 + r32) * 2) = f2bf(o0[r]); *(LAS bf16_t*)(stg + (q * 64 + 32 + r32) * 2) = f2bf(o1[r]); }
    WAVE_FENCE();
}

__device__ __forceinline__ void mixb_first(const bf16_t* __restrict__ proj, int b, int h, int jt, int lane, bf16x8 (&qr)[4], bf16x8 (&kf)[4], u32x4 (&vr)[4]) {
    const int r32 = lane & 31, hi = lane >> 5, t0 = jt * 32;
    const bf16_t* qb = proj + (size_t)b * SEQ * PROJ_LD + 1536 + h * 64;
#pragma unroll
    for (int d0 = 0; d0 < 4; ++d0) qr[d0] = *(const bf16x8*)(qb + (size_t)(t0 + r32) * PROJ_LD + d0 * 16 + hi * 8);
    mix_load_k(kf, qb + 512, t0, 1, 0, r32, hi); mix_load_v(vr, qb + 1024, t0, 1, 0, lane);
}
__device__ __forceinline__ void mixb_tile(const bf16_t* __restrict__ proj, bf16_t* __restrict__ oab, int b, int h, int jt, LAS char* wl, int lane, const bf16x8 (&qr)[4], bf16x8 (&kf)[4], u32x4 (&vr)[4]) {
    const int r32 = lane & 31, hi = lane >> 5, t0 = jt * 32;
    const bf16_t* qb = proj + (size_t)b * SEQ * PROJ_LD + 1536 + h * 64;
    f32x16 o0, o1;
#pragma unroll
    for (int r = 0; r < 16; ++r) { o0[r] = 0.f; o1[r] = 0.f; }
    float carry = 0.f;
    for (int kt = jt; kt >= 0; --kt) {
        LAS char* slot = wl + (kt & 1) * 4096;
        mix_store_v(vr, slot, lane);
        bf16x8 kn[4]; const int snext = (kt > 0 ? kt - 1 : 0) * 32;
        mix_load_k(kn, qb + 512, snext, 1, 0, r32, hi); mix_load_v(vr, qb + 1024, snext, 1, 0, lane);
        __builtin_amdgcn_sched_barrier(0);
        f32x16 z;
#pragma unroll
        for (int r = 0; r < 16; ++r) z[r] = 0.f;
#pragma unroll
        for (int d0 = 0; d0 < 4; ++d0) z = MFMA32(kf[d0], qr[d0], z);
        const bool diag = (kt == jt);
        float lk[16], ls[16];
#pragma unroll
        for (int r = 0; r < 16; ++r) { const float z2 = z[r]; const float e = __builtin_amdgcn_exp2f(-__builtin_fabsf(z2));
            const float sp = __builtin_fmaxf(z2, 0.f) + __builtin_amdgcn_logf(1.0f + e);
            const bool ok = !diag || (crow(r, hi) < r32);
            lk[r] = ok ? -sp : 0.f; ls[r] = ok ? (z2 - sp) : -INFINITY; }
        float G[4], PG[4], T[4];
#pragma unroll
        for (int c = 0; c < 4; ++c) { G[c] = (lk[4 * c] + lk[4 * c + 1]) + (lk[4 * c + 2] + lk[4 * c + 3]); PG[c] = __shfl_xor(G[c], 32); T[c] = G[c] + PG[c]; }
        const float ST2 = T[3], ST1 = T[3] + T[2], ST0 = ST1 + T[1];
        const float STc[4] = {ST0, ST1, ST2, 0.f};
        float a[16];
#pragma unroll
        for (int c = 0; c < 4; ++c) { float af = carry + STc[c] + (hi == 0 ? PG[c] : 0.f);
            a[4 * c + 3] = __builtin_amdgcn_exp2f(ls[4 * c + 3] + af); af += lk[4 * c + 3];
            a[4 * c + 2] = __builtin_amdgcn_exp2f(ls[4 * c + 2] + af); af += lk[4 * c + 2];
            a[4 * c + 1] = __builtin_amdgcn_exp2f(ls[4 * c + 1] + af); af += lk[4 * c + 1];
            a[4 * c + 0] = __builtin_amdgcn_exp2f(ls[4 * c + 0] + af); }
        carry += ST0 + T[0];
        u32x4 pw0, pw1;
        pw0.x = cvtpk(a[0], a[1]); pw0.y = cvtpk(a[2], a[3]); pw0.z = cvtpk(a[4], a[5]); pw0.w = cvtpk(a[6], a[7]);
        pw1.x = cvtpk(a[8], a[9]); pw1.y = cvtpk(a[10], a[11]); pw1.z = cvtpk(a[12], a[13]); pw1.w = cvtpk(a[14], a[15]);
        mix_pv(o0, o1, pw0, pw1, slot, lane);
        if (__all(carry < -126.0f)) break;
#pragma unroll
        for (int d0 = 0; d0 < 4; ++d0) kf[d0] = kn[d0];
    }
    LAS char* stg = wl + MIX_STG;
    mix_stage_o(o0, o1, stg, r32, hi);
    bf16_t* Ow = oab + ((size_t)b * SEQ + t0) * DM + 512 + h * 64;
#pragma unroll
    for (int i = 0; i < 4; ++i) { const int row = i * 8 + (lane >> 3), ch = lane & 7; *(u32x4*)(Ow + (size_t)row * DM + ch * 8) = *(const LAS u32x4*)(stg + row * 128 + ch * 16); }
}
__device__ __forceinline__ void phase_mix_b(const bf16_t* proj, bf16_t* oab) {
    int tidx = threadIdx.x; asm volatile("" : "+v"(tidx));
    const int wid = __builtin_amdgcn_readfirstlane(tidx >> 6), lane = tidx & 63;
    LAS char* wl = (LAS char*)dyn_lds + MIX_LDS_BASE + wid * MIX_WAVE_LDS;
    const int Gm = (int)gridDim.x, vcu = (Gm % 8 == 0) ? ((int)blockIdx.x % 8) * (Gm / 8) + (int)blockIdx.x / 8 : (int)blockIdx.x;
    const int u0 = vcu * 8 + wid, ustep = Gm * 8;
    bf16x8 qA[4], kA[4], qB[4], kB[4]; u32x4 vA[4], vB[4];
    if (u0 < 8192) mixb_first(proj, u0 >> 9, (u0 >> 6) & 7, u0 & 63, lane, qA, kA, vA);
    for (int u = u0; u < 8192; u += ustep) {
        const int bh = u >> 6, pj = u & 63, b = bh >> 3, h = bh & 7;
        mixb_first(proj, b, h, 127 - pj, lane, qB, kB, vB);
        __builtin_amdgcn_sched_barrier(0);
        mixb_tile(proj, oab, b, h, pj, wl, lane, qA, kA, vA);
        const int un = u + ustep;
        if (un < 8192) mixb_first(proj, un >> 9, (un >> 6) & 7, un & 63, lane, qA, kA, vA);
        __builtin_amdgcn_sched_barrier(0);
        mixb_tile(proj, oab, b, h, 127 - pj, wl, lane, qB, kB, vB);
    }
}

constexpr int MIXA_NOREL = -(1 << 30);
__device__ __forceinline__ void mixa_step(bf16x8 (&kc)[4], const bf16x8 (&qr)[4], int jk0, int jlo, int jhi, const LAS char* slot, LAS float* asc, int lane, float& m2, float& l, f32x16& o0, f32x16& o1, int jlo_u,
                                          const bf16_t* kbase = nullptr, int kre = MIXA_NOREL, int dil = 1, int rr = 0) {
    const int r32 = lane & 31, hi = lane >> 5;
    const bool first = (m2 == -INFINITY); const float zi = first ? 0.f : -m2;
    f32x16 z;
#pragma unroll
    for (int r = 0; r < 16; ++r) z[r] = zi;
#pragma unroll
    for (int d0 = 0; d0 < 4; ++d0) z = MFMA32(kc[d0], qr[d0], z);
    if (kre != MIXA_NOREL) { mix_load_k(kc, kbase, kre, dil, rr, r32, hi); __builtin_amdgcn_sched_barrier(0); }
    float tm = -INFINITY;
    if (jk0 >= 32 && jk0 <= 96 && jk0 >= jlo_u) {
#pragma unroll
        for (int r = 0; r < 16; ++r) tm = __builtin_fmaxf(tm, z[r]);
    } else {
#pragma unroll
        for (int r = 0; r < 16; ++r) { const int jk = jk0 + crow(r, hi); const float v = (jk >= jlo && jk <= jhi) ? z[r] : -INFINITY; z[r] = v; tm = __builtin_fmaxf(tm, v); }
    }
    tm = __builtin_fmaxf(tm, __shfl_xor(tm, 32));
    const float d = first ? (tm == -INFINITY ? 0.f : tm) : (tm > 8.0f ? tm : 0.f);
    m2 = first ? tm : m2 + d;
    float ps = 0.f;
    const float alpha = first ? 0.f : __builtin_amdgcn_exp2f(-d);
#pragma unroll
    for (int r = 0; r < 16; ++r) { const float pv = __builtin_amdgcn_exp2f(z[r] - d); z[r] = pv; ps += pv; }
    l = l * alpha + ps;
    if (__any(d != 0.f)) {
        WAVE_FENCE(); if (hi == 0) asc[r32] = alpha; WAVE_FENCE();
#pragma unroll
        for (int c = 0; c < 4; ++c) { const f32x4 a4 = *(const LAS f32x4*)(asc + 8 * c + 4 * hi);
#pragma unroll
            for (int j = 0; j < 4; ++j) { o0[4 * c + j] *= a4[j]; o1[4 * c + j] *= a4[j]; } } }
    u32x4 pw0, pw1;
    pw0.x = cvtpk(z[0], z[1]); pw0.y = cvtpk(z[2], z[3]); pw0.z = cvtpk(z[4], z[5]); pw0.w = cvtpk(z[6], z[7]);
    pw1.x = cvtpk(z[8], z[9]); pw1.y = cvtpk(z[10], z[11]); pw1.z = cvtpk(z[12], z[13]); pw1.w = cvtpk(z[14], z[15]);
    mix_pv(o0, o1, pw0, pw1, slot, lane);
}
__device__ __forceinline__ void mixa_tile(const bf16_t* __restrict__ qa, int l0, int dil, int rr, LAS char* wl, int lane, f32x16& o0, f32x16& o1, float& lse2, int abl) {
    const int r32 = lane & 31, hi = lane >> 5;
    bf16x8 qr[4];
#pragma unroll
    for (int d0 = 0; d0 < 4; ++d0) qr[d0] = *(const bf16x8*)(qa + (size_t)((l0 + r32) * dil + rr) * PROJ_LD + d0 * 16 + hi * 8);
    const int jlo = max(r32, 128 - l0), jhi = r32 + 128;
    bf16x8 ka[4], kb[4]; u32x4 va[4];
    mix_load_k(ka, qa + 512, l0 - 128, dil, rr, r32, hi); mix_load_k(kb, qa + 512, l0 - 96, dil, rr, r32, hi); mix_load_v(va, qa + 1024, l0 - 128, dil, rr, lane);
    __builtin_amdgcn_sched_barrier(0);
    float m2 = -INFINITY, l = 0.f;
#pragma unroll
    for (int r = 0; r < 16; ++r) { o0[r] = 0.f; o1[r] = 0.f; }
    LAS float* asc = (LAS float*)(wl + MIX_ASC);
    (void)abl;
#pragma unroll 1
    for (int kp = 0; kp < 4; kp += 2) {
        mix_store_v(va, wl, lane); mix_load_v(va, qa + 1024, l0 - 128 + 32 * (kp + 1), dil, rr, lane);
        __builtin_amdgcn_sched_barrier(0);
        mixa_step(ka, qr, 32 * kp, jlo, jhi, wl, asc, lane, m2, l, o0, o1, 128 - l0, qa + 512, l0 - 128 + 32 * (kp + 2), dil, rr);
        mix_store_v(va, wl + 4096, lane); mix_load_v(va, qa + 1024, l0 - 128 + 32 * (kp + 2), dil, rr, lane);
        __builtin_amdgcn_sched_barrier(0);
        mixa_step(kb, qr, 32 * (kp + 1), jlo, jhi, wl + 4096, asc, lane, m2, l, o0, o1, 128 - l0, qa + 512, kp + 3 < 5 ? l0 - 128 + 32 * (kp + 3) : MIXA_NOREL, dil, rr);
    }
    mix_store_v(va, wl, lane);
    mixa_step(ka, qr, 128, jlo, jhi, wl, asc, lane, m2, l, o0, o1, 128 - l0);
    l += __shfl_xor(l, 32);
    lse2 = m2 + __builtin_amdgcn_logf(l);
    const float rl = 1.0f / l;
#pragma unroll
    for (int r = 0; r < 16; ++r) { const float rq = __shfl(rl, crow(r, hi)); o0[r] *= rq; o1[r] *= rq; }
}
__device__ __forceinline__ void mixa_finish(float m2, float l, f32x16& o0, f32x16& o1, float& lse2, int lane) {
    const int hi = lane >> 5;
    l += __shfl_xor(l, 32);
    lse2 = m2 + __builtin_amdgcn_logf(l);
    const float rl = 1.0f / l;
#pragma unroll
    for (int r = 0; r < 16; ++r) { const float rq = __shfl(rl, crow(r, hi)); o0[r] *= rq; o1[r] *= rq; }
}
__device__ __forceinline__ void mixa_tile2(const bf16_t* __restrict__ qa, int l0, int dil, int rr, LAS char* wl, int lane,
                                           f32x16& a0, f32x16& a1, float& lseA, f32x16& b0, f32x16& b1, float& lseB) {
    const int r32 = lane & 31, hi = lane >> 5;
    bf16x8 qA[4], qB[4];
#pragma unroll
    for (int d0 = 0; d0 < 4; ++d0) { qA[d0] = *(const bf16x8*)(qa + (size_t)((l0 + r32) * dil + rr) * PROJ_LD + d0 * 16 + hi * 8); qB[d0] = *(const bf16x8*)(qa + (size_t)((l0 + 32 + r32) * dil + rr) * PROJ_LD + d0 * 16 + hi * 8); }
    const int jloA = max(r32, 128 - l0), jloB = max(r32, 128 - (l0 + 32)), jhi = r32 + 128;
    bf16x8 ka[4]; u32x4 va[4];
    mix_load_k(ka, qa + 512, l0 - 128, dil, rr, r32, hi); mix_load_v(va, qa + 1024, l0 - 128, dil, rr, lane);
    __builtin_amdgcn_sched_barrier(0);
    float mA = -INFINITY, lA = 0.f, mB = -INFINITY, lB = 0.f;
#pragma unroll
    for (int r = 0; r < 16; ++r) { a0[r] = 0.f; a1[r] = 0.f; b0[r] = 0.f; b1[r] = 0.f; }
    LAS float* asc = (LAS float*)(wl + MIX_ASC);
#pragma unroll 1
    for (int kt = 0; kt < 6; ++kt) {
        LAS char* slot = wl + (kt & 1) * 4096;
        mix_store_v(va, slot, lane);
        mix_load_v(va, qa + 1024, l0 - 128 + 32 * (kt + 1 < 6 ? kt + 1 : 5), dil, rr, lane);
        bf16x8 kc[4];
#pragma unroll
        for (int d0 = 0; d0 < 4; ++d0) kc[d0] = ka[d0];
        mix_load_k(ka, qa + 512, l0 - 128 + 32 * (kt + 1 < 6 ? kt + 1 : 5), dil, rr, r32, hi);
        __builtin_amdgcn_sched_barrier(0);
        if (kt < 5) mixa_step(kc, qA, 32 * kt, jloA, jhi, slot, asc, lane, mA, lA, a0, a1, 128 - l0);
        if (kt > 0) mixa_step(kc, qB, 32 * (kt - 1), jloB, jhi, slot, asc, lane, mB, lB, b0, b1, 128 - (l0 + 32));
    }
    mixa_finish(mA, lA, a0, a1, lseA, lane); mixa_finish(mB, lB, b0, b1, lseB, lane);
}
__device__ __forceinline__ void mixa_epi_merge2(const f32x16& o0, const f32x16& o1, float lse1, LAS char* wl, LAS char* stg, LAS char* park, LAS float* plse, int lfirst  , int dil, int lane) {
    const int r32 = lane & 31, hi = lane >> 5;
    mix_stage_o(o0, o1, stg, r32, hi);
    WAVE_FENCE(); if (hi == 0) *(LAS float*)(wl + r32 * 4) = lse1; WAVE_FENCE();
#pragma unroll
    for (int i = 0; i < 4; ++i) { const int row = i * 8 + (lane >> 3), ch = lane & 7; const int loc = lfirst + row * dil;
        const float e1 = *(const LAS float*)(wl + row * 4), e0 = plse[loc];
        const float M = __builtin_fmaxf(e0, e1);
        float w0 = __builtin_amdgcn_exp2f(e0 - M), w1 = __builtin_amdgcn_exp2f(e1 - M); const float sm = w0 + w1, inv = __builtin_amdgcn_rcpf(sm); w0 *= inv; w1 *= inv;
        const u32x4 c1 = *(const LAS u32x4*)(stg + row * 128 + ch * 16), c0 = *(const LAS u32x4*)(park + loc * 128 + ch * 16);
        u32x4 out;
#pragma unroll
        for (int k = 0; k < 4; ++k) { const float lo = w0 * bf2f(c0[k] & 0xffff) + w1 * bf2f(c1[k] & 0xffff), hh = w0 * bf2f(c0[k] >> 16) + w1 * bf2f(c1[k] >> 16); out[k] = cvtpk(lo, hh); }
        WAVE_FENCE();
        *(LAS u32x4*)(park + loc * 128 + ch * 16) = out; if (ch == 0) plse[loc] = M + __builtin_amdgcn_logf(sm);
        WAVE_FENCE(); }
}
__device__ __forceinline__ void mixa_epi_merge(const f32x16& o0, const f32x16& o1, float lse2, LAS char* wl, LAS char* stg, const LAS char* park, const LAS float* plse, bf16_t* oab, int bh, int B0, int l0, int dil, int rr, int lane) {
    const int r32 = lane & 31, hi = lane >> 5;
    mix_stage_o(o0, o1, stg, r32, hi);
    WAVE_FENCE(); if (hi == 0) *(LAS float*)(wl + r32 * 4) = lse2; WAVE_FENCE();
    const size_t rowb = (size_t)(bh >> 3) * SEQ; const int hc = (bh & 7) * 64;
#pragma unroll
    for (int i = 0; i < 4; ++i) { const int row = i * 8 + (lane >> 3), ch = lane & 7; const int pos = (l0 + row) * dil + rr, loc = pos - B0;
        const float e2 = *(const LAS float*)(wl + row * 4), e0 = plse[loc];
        const float M = __builtin_fmaxf(e2, e0);
        float w0 = __builtin_amdgcn_exp2f(e0 - M), w2 = __builtin_amdgcn_exp2f(e2 - M); const float inv = __builtin_amdgcn_rcpf(w0 + w2); w0 *= inv; w2 *= inv;
        const u32x4 c2 = *(const LAS u32x4*)(stg + row * 128 + ch * 16), c0 = *(const LAS u32x4*)(park + loc * 128 + ch * 16);
        u32x4 out;
#pragma unroll
        for (int k = 0; k < 4; ++k) { const float lo = w0 * bf2f(c0[k] & 0xffff) + w2 * bf2f(c2[k] & 0xffff), hh = w0 * bf2f(c0[k] >> 16) + w2 * bf2f(c2[k] >> 16); out[k] = cvtpk(lo, hh); }
        *(u32x4*)(oab + (rowb + pos) * DM + hc + ch * 8) = out; }
}
__device__ __forceinline__ void phase_mix_a(const bf16_t* proj, bf16_t* oab, int abl) {
    int tidx = threadIdx.x; asm volatile("" : "+v"(tidx));
    const int wid = __builtin_amdgcn_readfirstlane(tidx >> 6), lane = tidx & 63, r32 = lane & 31, hi = lane >> 5;
    LAS char* wl = (LAS char*)dyn_lds + MIX_LDS_BASE + wid * MIX_WAVE_LDS; LAS char* stg = wl + MIX_STG;
    LAS char* park = (LAS char*)dyn_lds + MIX_PARK; LAS float* plse = (LAS float*)((LAS char*)dyn_lds + MIX_PLSE);
    const int Gm = (int)gridDim.x, vcu = (Gm % 8 == 0) ? ((int)blockIdx.x % 8) * (Gm / 8) + (int)blockIdx.x / 8 : (int)blockIdx.x;
    for (int u = vcu; u < 1024; u += Gm) {
        const int bh = u >> 3, blk = u & 7, b = bh >> 3, h = bh & 7, B0 = blk * 512;
        const bf16_t* qa = proj + (size_t)b * SEQ * PROJ_LD + h * 64;
        {
            const int l0 = B0 + 64 * wid; f32x16 a0, a1, b0, b1; float lsA, lsB;
            mixa_tile2(qa, l0, 1, 0, wl, lane, a0, a1, lsA, b0, b1, lsB);
            mix_stage_o(a0, a1, park + (l0 - B0) * 128, r32, hi); mix_stage_o(b0, b1, park + (l0 + 32 - B0) * 128, r32, hi);
            if (hi == 0) { plse[l0 - B0 + r32] = lsA; plse[l0 + 32 - B0 + r32] = lsB; } }
        {
            const int T1 = B0 + 256 * (wid >> 2) + (wid & 3), l0 = T1 / 4, rr = T1 % 4; f32x16 a0, a1, b0, b1; float lsA, lsB;
            mixa_tile2(qa, l0, 4, rr, wl, lane, a0, a1, lsA, b0, b1, lsB);
            __syncthreads();
            mixa_epi_merge2(a0, a1, lsA, wl, stg, park, plse, l0 * 4 + rr - B0, 4, lane);
            mixa_epi_merge2(b0, b1, lsB, wl, stg, park, plse, (l0 + 32) * 4 + rr - B0, 4, lane); }
        __syncthreads();
#pragma unroll 1
        for (int rep = 0; rep < 2; ++rep) {
            const int rr = 2 * wid + rep, l0 = B0 / 16;
            f32x16 o0, o1; float lse2;
            mixa_tile(qa, l0, 16, rr, wl, lane, o0, o1, lse2, abl);
            mixa_epi_merge(o0, o1, lse2, wl, stg, park, plse, oab, bh, B0, l0, 16, rr, lane);
        }
        __syncthreads();
    }
}

namespace pg8 {
#define PG8_LAS __attribute__((address_space(3)))
constexpr int BM = 256, BK = 64, HALF = 128, HTB = HALF * BK * 2, STAGE_BYTES = 8 * HTB, NXCD = 8, WGM = 8;
__device__ __forceinline__ int lds_byte(int r, int c) { const int st = (r >> 4) * 2 + (c >> 5), rr = r & 15, cc = c & 31, ob = rr * 64 + cc * 2; return st * 1024 + (ob ^ (((ob >> 9) & 1) << 5)); }
__device__ __forceinline__ void stage_rc(int b, int& R, int& C) { const int st = b / 1024, sb = b % 1024, swz = sb ^ (((sb >> 9) & 1) << 5); R = (st >> 1) * 16 + swz / 64; C = (st & 1) * 32 + (swz % 64) / 2; }
__device__ __forceinline__ int perm32(int rho) { const int n = rho >> 4, i = rho & 15; return 8 * (i >> 2) + 4 * n + (i & 3); }
__device__ __forceinline__ void dma1k_(const void* g  , PG8_LAS unsigned char* dst) { __builtin_amdgcn_global_load_lds((const unsigned*)g, (PG8_LAS unsigned*)dst, 16, 0, 0); }
struct Unit { int pm, pn, e; };
struct Gemm { const void* A; const void* Bt; const int* rowidx; int lda_b, kb, b_erows; };
struct StaticOrder {
    int nM, nN, nwg, G, c;
    __device__ void init(int M, int N, int G_, int c_) { nM = M / BM; nN = N / BM; nwg = nM * nN; G = G_; c = c_; }
    __device__ bool next(int i, Unit& u) const {
        const long L = (long)i * G + c; if (L >= nwg) return false;
        int wgid = (int)L; { const int q = nwg / NXCD, r = nwg % NXCD, xcd = wgid % NXCD, off = wgid / NXCD; wgid = (xcd < r ? xcd * (q + 1) : r * (q + 1) + (xcd - r) * q) + off; }
        const int nig = WGM * nN, gid = wgid / nig, fm = gid * WGM, gsz = (nM - fm) < WGM ? (nM - fm) : WGM;
        u.pm = fm + ((wgid % nig) % gsz); u.pn = (wgid % nig) / gsz; u.e = 0; return true;
    }
};
struct MoeOrder {
    int t0, T, NC, G, c; const int* tile_e;
    __device__ bool next(int i, Unit& u) const {
        int tb = t0, Tx = T, per = G, loc = c;
        if (G % 8 == 0) { per = G / 8; const int x = c / per; loc = c - x * per; tb = t0 + (int)(((long)T * x) >> 3); Tx = t0 + (int)(((long)T * (x + 1)) >> 3) - tb; }
        const long L = (long)i * per + loc; if (L >= (long)Tx * NC) return false;
        const int gi = (int)(L / (4 * NC)), w = (int)(L % (4 * NC)), rem = Tx - gi * 4, gsz = rem < 4 ? rem : 4;
        u.pm = tb + gi * 4 + w % gsz; u.pn = w / gsz; u.e = tile_e[u.pm]; return true;
    }
};
typedef int i32x4 __attribute__((ext_vector_type(4)));
typedef int i32x8 __attribute__((ext_vector_type(8)));
template <int MODE> struct AccT { typedef f32x4 type; }; template <> struct AccT<1> { typedef i32x4 type; };
template <class Epi, class Sched, bool GATHER, bool ALIGN_EPI, int MODE = 0, bool DUAL = false>
__device__ __forceinline__ void gemm_phase(PG8_LAS unsigned char* lds, const Gemm g, const Sched& S, const Epi& E) {
    int tid = threadIdx.x; asm volatile("" : "+v"(tid));
    const int wid = __builtin_amdgcn_readfirstlane(tid >> 6), lane = tid & 63, wr = wid >> 2, wc = wid & 3, fr = lane & 15, fq = lane >> 4;
    const int KB = g.kb, nt = KB / 128; typedef typename AccT<MODE>::type accv; constexpr bool I8 = (MODE == 1), F8 = (MODE == 2);
    int sR[2], sC[2]; unsigned voffB[2], voffA[2];
#pragma unroll
    for (int i = 0; i < 2; ++i) { stage_rc(tid * 16 + i * 8192, sR[i], sC[i]); const int Rb = Epi::PERM ? ((sR[i] & ~31) + perm32(sR[i] & 31)) : sR[i]; voffB[i] = (unsigned)(Rb * KB + sC[i] * 2); voffA[i] = (unsigned)(sR[i] * g.lda_b + sC[i] * 2); }
    const size_t hstepA = (size_t)HALF * g.lda_b, tstepA = 2 * hstepA;
    const size_t kstep = (size_t)(BK * 2);
    const size_t hstepB = (size_t)HALF * KB;
    const unsigned ldsw = (unsigned)wid * 1024u;
    const int aoff = F8 ? lds_byte(wr * 64 + fr, fq * 16) : lds_byte(wr * 64 + fr, fq * 8), boff = F8 ? lds_byte(wc * 32 + fr, fq * 16) : lds_byte(wc * 32 + fr, fq * 8);
#define PG8_UOFF(dst, u) do { _Pragma("unroll") for (int h_ = 0; h_ < 2; ++h_) _Pragma("unroll") for (int i_ = 0; i_ < 2; ++i_) { int row_ = (u).pm * BM + h_ * HALF + sR[i_]; \
        if (GATHER) { row_ = g.rowidx[row_]; row_ = row_ < 0 ? 0 : row_; } dst[h_][i_] = (unsigned)(row_ * g.lda_b + sC[i_] * 2); } } while (0)
#define PG8_SA(b, h) (((b) * 2 + (h)) * HTB)
#define PG8_SB(b, h) ((4 + (b) * 2 + (h)) * HTB)
#define PG8_STAGE(bufoff, gbase, voff) do { _Pragma("unroll") for (int _i = 0; _i < 2; ++_i) \
        __builtin_amdgcn_global_load_lds((const unsigned*)((const char*)(gbase) + (voff)[_i]), (PG8_LAS unsigned*)(lds + (bufoff) + ldsw + _i * 8192), 16, 0, 0); } while (0)
#define PG8_STAGE_A(bufoff, kofs, hh, ubase, uoff) do { if constexpr (GATHER) { PG8_STAGE(bufoff, gA + (kofs), uoff[hh]); } else { PG8_STAGE(bufoff, (ubase) + (kofs) + (hh) * hstepA, voffA); } } while (0)
#define PG8_LDA(dst, b, h) do { if constexpr (F8) { _Pragma("unroll") for (int m = 0; m < 4; ++m) dst##8[m] = *(const PG8_LAS i32x8*)(lds + PG8_SA(b, h) + aoff + m * 2048); } \
        else { _Pragma("unroll") for (int m = 0; m < 4; ++m) _Pragma("unroll") for (int k = 0; k < 2; ++k) dst[m][k] = *(const PG8_LAS bf16x8*)(lds + PG8_SA(b, h) + aoff + m * 2048 + k * 1024); } } while (0)
#define PG8_LDB(dst, b, h) do { if constexpr (F8) { _Pragma("unroll") for (int n = 0; n < 2; ++n) dst##8[n] = *(const PG8_LAS i32x8*)(lds + PG8_SB(b, h) + boff + n * 2048); } \
        else { _Pragma("unroll") for (int n = 0; n < 2; ++n) _Pragma("unroll") for (int k = 0; k < 2; ++k) dst[n][k] = *(const PG8_LAS bf16x8*)(lds + PG8_SB(b, h) + boff + n * 2048 + k * 1024); } } while (0)
#define PG8_LDB1(dst, b, h) PG8_LDB(dst, b, h)
#define PG8_MMA(ai, bj, At, Bt) do { __builtin_amdgcn_s_setprio(1); _Pragma("unroll") for (int m = 0; m < 4; ++m) _Pragma("unroll") for (int n = 0; n < 2; ++n) { \
        if constexpr (F8) { asm volatile("v_mfma_f32_16x16x128_f8f6f4 %0, %1, %2, %0" : "+v"(acc[ai][bj][m][n]) : "v"(Bt##8[n]), "v"(At##8[m])); } \
        else { _Pragma("unroll") for (int k = 0; k < 2; ++k) { \
          if constexpr (I8) acc[ai][bj][m][n] = __builtin_amdgcn_mfma_i32_16x16x64_i8(__builtin_bit_cast(i32x4, Bt[n][k]), __builtin_bit_cast(i32x4, At[m][k]), acc[ai][bj][m][n], 0, 0, 0); \
          else acc[ai][bj][m][n] = __builtin_amdgcn_mfma_f32_16x16x32_bf16(Bt[n][k], At[m][k], acc[ai][bj][m][n], 0, 0, 0); } } } __builtin_amdgcn_s_setprio(0); } while (0)
#define PG8_WAIT_V(n) asm volatile("s_waitcnt vmcnt(" #n ")" ::: "memory")
#define PG8_WAIT_L(n) asm volatile("s_waitcnt lgkmcnt(" #n ")" ::: "memory")
#define PG8_BAR __builtin_amdgcn_s_barrier()
#define PG8_SCHED __builtin_amdgcn_sched_barrier(0)
    Unit cur, nxt; int ui = 0;
    if (!S.next(0, cur)) return;
    typename Epi::Early ev;
    accv acc[2][2][4][2];
#pragma unroll
    for (int a = 0; a < 2; ++a)
#pragma unroll
        for (int b = 0; b < 2; ++b)
#pragma unroll
            for (int m = 0; m < 4; ++m)
#pragma unroll
                for (int n = 0; n < 2; ++n) acc[a][b][m][n] = (accv){0, 0, 0, 0};
    bf16x8 At[4][2], B0[2][2], B1[2][2]; i32x8 At8[4], B08[2], B18[2];
    unsigned oA[2][2];
    if constexpr (GATHER) PG8_UOFF(oA, cur);
    const char* const gA = (const char*)g.A;
    const size_t ustepA = DUAL ? hstepA : tstepA;
    const char* cA = gA + (GATHER ? (size_t)0 : (size_t)cur.pm * ustepA);
    constexpr int BN = BM;
    const char* cB = (const char*)g.Bt + ((size_t)cur.e * g.b_erows + (size_t)cur.pn * BN) * KB;
    unsigned o0 = 0, o1 = 3 * HTB, o2 = 6 * HTB;
#define PG8_D3STAGE(off, ko, bA_, bB_) do { PG8_STAGE((off), (bB_) + (ko), voffB); PG8_STAGE((off) + HTB, (bB_) + hstepB + (ko), voffB); PG8_STAGE((off) + 2 * HTB, (bA_) + (ko), voffA); } while (0)
    if constexpr (DUAL) {
        PG8_D3STAGE(o0, 0, cA, cB); PG8_D3STAGE(o1, kstep, cA, cB);
        if (wr == 1) PG8_BAR;
        PG8_WAIT_V(6); PG8_BAR; PG8_BAR;
    } else {
    PG8_STAGE(PG8_SB(0, 0), cB, voffB); PG8_STAGE(PG8_SB(0, 1), cB + hstepB, voffB); PG8_STAGE_A(PG8_SA(0, 0), 0, 0, cA, oA); PG8_STAGE_A(PG8_SA(0, 1), 0, 1, cA, oA);
    if (wr == 1) PG8_BAR;
    PG8_WAIT_V(2); PG8_BAR;
    PG8_STAGE(PG8_SB(1, 0), cB + kstep, voffB); PG8_STAGE_A(PG8_SA(1, 0), kstep, 0, cA, oA); PG8_STAGE(PG8_SB(1, 1), cB + hstepB + kstep, voffB);
    PG8_WAIT_V(6); PG8_BAR;
    }
    PG8_LAS int* const ridx = (PG8_LAS int*)(lds + STAGE_BYTES + 4096);
    for (;;) {
        const bool has_next = S.next(ui + 1, nxt);
        const char* nA = (has_next && !GATHER) ? gA + (size_t)nxt.pm * ustepA : cA;
        const char* nB = has_next ? (const char*)g.Bt + ((size_t)nxt.e * g.b_erows + (size_t)nxt.pn * BN) * KB : cB;
        if constexpr (DUAL) {
#pragma unroll
            for (int s = 0; s < 2; ++s) {
#pragma unroll 1
                for (int kt = s * (nt / 2); kt < (s + 1) * (nt / 2); ++kt) {
                    const bool nx_ = (kt + 2 >= nt); const size_t ko_ = (size_t)(nx_ ? kt + 2 - nt : kt + 2) * kstep; const char* bA_ = nx_ ? nA : cA; const char* bB_ = nx_ ? nB : cB;
#pragma unroll
                    for (int n = 0; n < 2; ++n)
#pragma unroll
                        for (int k = 0; k < 2; ++k) { B0[n][k] = *(const PG8_LAS bf16x8*)(lds + o0 + boff + n * 2048 + k * 1024); B1[n][k] = *(const PG8_LAS bf16x8*)(lds + o0 + HTB + boff + n * 2048 + k * 1024); }
                    PG8_SCHED;
#pragma unroll
                    for (int m = 0; m < 4; ++m)
#pragma unroll
                        for (int k = 0; k < 2; ++k) At[m][k] = *(const PG8_LAS bf16x8*)(lds + o0 + 2 * HTB + aoff + m * 2048 + k * 1024);
                    PG8_D3STAGE(o2, ko_, bA_, bB_);
                    if (Epi::NEARLY > 0 && kt == nt - 1) { E.early(cur, wr, wc, fr, fq, ev); asm volatile("s_waitcnt vmcnt(%0)" :: "n"(6 + Epi::NEARLY) : "memory"); } else PG8_WAIT_V(6);
                    PG8_WAIT_L(0); PG8_BAR; PG8_MMA(s, 0, At, B0); PG8_MMA(s, 1, At, B1); PG8_BAR; PG8_SCHED;
                    const unsigned ot_ = o0; o0 = o1; o1 = o2; o2 = ot_;
                }
            }
        } else {
        constexpr int NS = 1; const int nh = nt;
#pragma unroll
        for (int s = 0; s < NS; ++s) {
#pragma unroll 1
        for (int t = s * nh; t < (s + 1) * nh; t += 2) {
            const bool last = (t == nt - 2);
            if constexpr (GATHER) { if (t == 0 && wid == 4) dma1k_(g.rowidx + (has_next ? nxt.pm : cur.pm) * BM + 4 * lane, (PG8_LAS unsigned char*)ridx); }
            if (last) E.pre(cur, lds + STAGE_BYTES, wid, lane);
            const size_t k1 = (size_t)(t + 1) * kstep, k2 = last ? (size_t)0 : (size_t)(t + 2) * kstep, k3 = k2 + kstep;
            const char* b2 = last ? nB : cB + (size_t)(t + 2) * kstep; const char* b3 = b2 + kstep;
            {
            PG8_LDB(B0, 0, 0); PG8_LDB(B1, 0, 1); PG8_SCHED; PG8_LDA(At, 0, 0); PG8_STAGE_A(PG8_SA(1, 1), k1, 1, cA, oA);
            if (last) { cA = nA;
                if constexpr (GATHER) {
#pragma unroll
                    for (int h_ = 0; h_ < 2; ++h_)
#pragma unroll
                        for (int i_ = 0; i_ < 2; ++i_) { int row_ = ridx[h_ * HALF + sR[i_]]; row_ = row_ < 0 ? 0 : row_; oA[h_][i_] = (unsigned)(row_ * g.lda_b + sC[i_] * 2); } } }
            PG8_WAIT_V(8); PG8_WAIT_L(0); PG8_BAR; PG8_MMA(0, 0, At, B0); PG8_MMA(0, 1, At, B1); PG8_BAR; PG8_SCHED;
            PG8_LDA(At, 0, 1); PG8_STAGE(PG8_SB(0, 0), b2, voffB); PG8_STAGE(PG8_SB(0, 1), b2 + hstepB, voffB); PG8_STAGE_A(PG8_SA(0, 0), k2, 0, cA, oA);
            PG8_WAIT_V(8); PG8_WAIT_L(0); PG8_BAR; PG8_MMA(1, 0, At, B0); PG8_MMA(1, 1, At, B1); PG8_BAR; PG8_SCHED;
            PG8_LDB(B0, 1, 0); PG8_LDB(B1, 1, 1); PG8_SCHED; PG8_LDA(At, 1, 0); PG8_STAGE_A(PG8_SA(0, 1), k2, 1, cA, oA);
            PG8_WAIT_V(8); PG8_WAIT_L(0); PG8_BAR; PG8_MMA(0, 0, At, B0); PG8_MMA(0, 1, At, B1); PG8_BAR; PG8_SCHED;
            PG8_LDA(At, 1, 1); PG8_STAGE(PG8_SB(1, 0), b3, voffB); PG8_STAGE(PG8_SB(1, 1), b3 + hstepB, voffB); PG8_STAGE_A(PG8_SA(1, 0), k3, 0, cA, oA);
            if (Epi::NEARLY > 0 && last) { E.early(cur, wr, wc, fr, fq, ev); asm volatile("s_waitcnt vmcnt(%0)" :: "n"(8 + Epi::NEARLY) : "memory"); } else PG8_WAIT_V(8);
            PG8_WAIT_L(0); PG8_BAR; PG8_MMA(1, 0, At, B0); PG8_MMA(1, 1, At, B1); PG8_BAR; PG8_SCHED;
            }
        }
        }
        }
        if constexpr (ALIGN_EPI) { if (wr == 0) PG8_BAR; }
        if constexpr (F8) asm volatile("s_nop 15\n\ts_nop 15" ::: "memory");
        if constexpr (Epi::NEARLY > 0) E.with_early(acc, cur, wr, wc, fr, fq, lds + STAGE_BYTES, ev); else E(acc, cur, wr, wc, fr, fq, lds + STAGE_BYTES);
        if (!has_next) break;
#pragma unroll
        for (int a = 0; a < 2; ++a)
#pragma unroll
            for (int b = 0; b < 2; ++b)
#pragma unroll
                for (int m = 0; m < 4; ++m)
#pragma unroll
                    for (int n = 0; n < 2; ++n) acc[a][b][m][n] = (accv){0, 0, 0, 0};
        cur = nxt; cB = nB; ++ui;
        if constexpr (DUAL) cA = nA;
        if constexpr (ALIGN_EPI) { if (wr == 1) PG8_BAR; }
    }
    PG8_WAIT_V(0);
    if constexpr (!ALIGN_EPI) { if (wr == 0) PG8_BAR; }
    PG8_BAR;
#undef PG8_UOFF
#undef PG8_SA
#undef PG8_SB
#undef PG8_STAGE
#undef PG8_STAGE_A
#undef PG8_LDA
#undef PG8_LDB
#undef PG8_LDB1
#undef PG8_D3STAGE
#undef PG8_MMA
#undef PG8_WAIT_V
#undef PG8_WAIT_L
#undef PG8_BAR
#undef PG8_SCHED
}
typedef f32x4 Acc[2][2][4][2];
typedef PG8_LAS unsigned char* SpP;
__device__ __forceinline__ void dma1k(const void* g  , SpP dst) { __builtin_amdgcn_global_load_lds((const unsigned*)g, (PG8_LAS unsigned*)dst, 16, 0, 0); }
__device__ __forceinline__ u32x4 pack8(const f32x4& v0, const f32x4& v1) { u32x4 w; w.x = cvtpk(v0[0], v0[1]); w.y = cvtpk(v0[2], v0[3]); w.z = cvtpk(v1[0], v1[1]); w.w = cvtpk(v1[2], v1[3]); return w; }
__device__ __forceinline__ void unpack8(const u32x4& w, f32x4& v0, f32x4& v1) { v0[0] = bf2f(w.x & 0xffff); v0[1] = bf2f(w.x >> 16); v0[2] = bf2f(w.y & 0xffff); v0[3] = bf2f(w.y >> 16); v1[0] = bf2f(w.z & 0xffff); v1[1] = bf2f(w.z >> 16); v1[2] = bf2f(w.w & 0xffff); v1[3] = bf2f(w.w >> 16); }
struct EpiInProjF {
    static constexpr bool PERM = true;
    bf16_t* proj; bf16_t* gate; const float* bgate; const float* rope;
    __device__ __forceinline__ void operator()(const Acc& acc, const Unit& u, int wr, int wc, int fr, int fq, SpP sp) const {
        const int row0 = u.pm * BM + wr * 64 + fr, colt = u.pn * BM + wc * 32 + 8 * fq; const bool isg = colt >= PROJ_NC;
        if (u.pn < 4 && (wc & 1) == 0) {
            const float sgn = fq == 0 ? -1.0f : 1.0f; const bool rot = fq < 2;
#pragma unroll
            for (int ai = 0; ai < 2; ++ai)
#pragma unroll
                for (int m = 0; m < 4; ++m) { const size_t row = (size_t)(row0 + ai * HALF + m * 16); const int pos = (int)(row & (SEQ - 1));
                    (void)pos; const int rl = (wr * 64 + fr + ai * HALF + m * 16) * 32;
                    const f32x4 c0 = *(const PG8_LAS f32x4*)(sp + 8192 + rl), c1 = *(const PG8_LAS f32x4*)(sp + 8192 + rl + 16), s0 = *(const PG8_LAS f32x4*)(sp + 16384 + rl), s1 = *(const PG8_LAS f32x4*)(sp + 16384 + rl + 16);
#pragma unroll
                    for (int bj = 0; bj < 2; ++bj) { f32x4 v0 = acc[ai][bj][m][0], v1 = acc[ai][bj][m][1], q0, q1;
#pragma unroll
                        for (int k = 0; k < 4; ++k) { q0[k] = __shfl_xor(v0[k], 16); q1[k] = __shfl_xor(v1[k], 16); }
                        if (rot) { v0 = v0 * c0 + q0 * s0 * sgn; v1 = v1 * c1 + q1 * s1 * sgn; }
                        *(u32x4*)(proj + row * PROJ_LD + colt + bj * HALF) = pack8(v0, v1); } }
            return;
        }
#pragma unroll
        for (int bj = 0; bj < 2; ++bj) { const int col = colt + bj * HALF; f32x4 b0 = (f32x4){0.f, 0.f, 0.f, 0.f}, b1 = b0;
            if (isg) { b0 = *(const PG8_LAS f32x4*)(sp + 2048 + (bj * HALF + wc * 32 + 8 * fq) * 4) * -1.4426950408889634f; b1 = *(const PG8_LAS f32x4*)(sp + 2048 + (bj * HALF + wc * 32 + 8 * fq) * 4 + 16) * -1.4426950408889634f; }
#pragma unroll
            for (int ai = 0; ai < 2; ++ai)
#pragma unroll
                for (int m = 0; m < 4; ++m) { const size_t row = (size_t)(row0 + ai * HALF + m * 16); f32x4 v0 = acc[ai][bj][m][0], v1 = acc[ai][bj][m][1];
                    if (isg) { v0 += b0; v1 += b1;
#pragma unroll
                        for (int k = 0; k < 4; ++k) { v0[k] = __builtin_amdgcn_rcpf(1.0f + __builtin_amdgcn_exp2f(v0[k])); v1[k] = __builtin_amdgcn_rcpf(1.0f + __builtin_amdgcn_exp2f(v1[k])); }
                        u32x2 gw;
                        { unsigned q0 = __float_as_uint(__builtin_fmaf(v0[0], 255.f, 8388608.f)), q1 = __float_as_uint(__builtin_fmaf(v0[1], 255.f, 8388608.f)), q2 = __float_as_uint(__builtin_fmaf(v0[2], 255.f, 8388608.f)), q3 = __float_as_uint(__builtin_fmaf(v0[3], 255.f, 8388608.f));
                          gw.x = __builtin_amdgcn_perm(__builtin_amdgcn_perm(q3, q2, 0x0c0c0400u), __builtin_amdgcn_perm(q1, q0, 0x0c0c0400u), 0x05040100u);
                          q0 = __float_as_uint(__builtin_fmaf(v1[0], 255.f, 8388608.f)); q1 = __float_as_uint(__builtin_fmaf(v1[1], 255.f, 8388608.f)); q2 = __float_as_uint(__builtin_fmaf(v1[2], 255.f, 8388608.f)); q3 = __float_as_uint(__builtin_fmaf(v1[3], 255.f, 8388608.f));
                          gw.y = __builtin_amdgcn_perm(__builtin_amdgcn_perm(q3, q2, 0x0c0c0400u), __builtin_amdgcn_perm(q1, q0, 0x0c0c0400u), 0x05040100u); }
                        *(u32x2*)((unsigned char*)gate + row * GATE_LD + col - PROJ_NC) = gw; }
                    else *(u32x4*)(proj + row * PROJ_LD + col) = pack8(v0, v1); } }
    }
};
struct EpiInProjI {
    struct Early {}; static constexpr int NEARLY = 0; __device__ __forceinline__ void early(const Unit&, int, int, int, int, Early&) const {}
    static constexpr bool PERM = true;
    EpiInProjF f; const float* sx; const float* sw;
    __device__ __forceinline__ void pre(const Unit& u, SpP sp, int wid, int lane) const {
        if (wid == 0) dma1k(sx + u.pm * BM + 4 * lane, sp); else if (wid == 1) dma1k(sw + u.pn * BM + 4 * lane, sp + 1024);
        else if (wid == 2 && u.pn * BM >= PROJ_NC) dma1k(f.bgate + u.pn * BM - PROJ_NC + 4 * lane, sp + 2048);
        if (u.pn < 4) { const float* rp = f.rope + (size_t)((u.pm * BM) & (SEQ - 1)) * 8 + wid * 256 + 4 * lane;
            dma1k(rp, sp + 8192 + wid * 1024); dma1k(rp + SEQ * 8, sp + 16384 + wid * 1024); }
    }
    __device__ __forceinline__ void operator()(const i32x4 (&acc)[2][2][4][2], const Unit& u, int wr, int wc, int fr, int fq, SpP sp) const {
        Acc v; const float gsc = (u.pn * BM >= PROJ_NC) ? -1.4426950408889634f : 1.0f;
#pragma unroll
        for (int ai = 0; ai < 2; ++ai)
#pragma unroll
            for (int m = 0; m < 4; ++m) { const float sr = *(const PG8_LAS float*)(sp + (wr * 64 + fr + ai * HALF + m * 16) * 4) * gsc;
#pragma unroll
                for (int bj = 0; bj < 2; ++bj) { const PG8_LAS f32x4* cp = (const PG8_LAS f32x4*)(sp + 1024 + (bj * HALF + wc * 32 + 8 * fq) * 4); const f32x4 c0 = cp[0] * sr, c1 = cp[1] * sr;
#pragma unroll
                    for (int k = 0; k < 4; ++k) { v[ai][bj][m][0][k] = (float)acc[ai][bj][m][0][k] * c0[k]; v[ai][bj][m][1][k] = (float)acc[ai][bj][m][1][k] * c1[k]; } } }
        f(v, u, wr, wc, fr, fq, sp);
    }
};
struct EpiProjF {
    static constexpr bool PERM = true;
    const bf16_t* gate; bf16_t* merged; int first; int pad_;
    __device__ __forceinline__ void pre(const Unit&, SpP, int, int) const {}
    __device__ __forceinline__ void operator()(const Acc& acc, const Unit& u, int wr, int wc, int fr, int fq, SpP) const {
        const int row0 = u.pm * BM + wr * 64 + fr, colt = u.pn * BM + wc * 32 + 8 * fq;
        const unsigned char* gp = (const unsigned char*)gate + (size_t)row0 * GATE_LD + (first ? 0 : DM) + colt; bf16_t* mp = merged + (size_t)row0 * DM + colt;
        constexpr int D = 4; u32x2 gw[16]; u32x4 pv[16];
#define PROJ_OFF(i) ((((i) >> 2) & 1) * HALF + ((i) & 3) * 16)
#define PROJ_LD_(i) do { gw[i] = *(const u32x2*)(gp + (size_t)PROJ_OFF(i) * GATE_LD + ((i) >> 3) * HALF); if (!first) pv[i] = *(const u32x4*)(mp + (size_t)PROJ_OFF(i) * DM + ((i) >> 3) * HALF); } while (0)
#pragma unroll
        for (int i = 0; i < D; ++i) PROJ_LD_(i);
#pragma unroll
        for (int i = 0; i < 16; ++i) { if (i + D < 16) PROJ_LD_(i + D);
            __builtin_amdgcn_sched_barrier(0);
            const int bj = i >> 3, ai = (i >> 2) & 1, m = i & 3; f32x4 g0, g1;
#pragma unroll
            for (int k = 0; k < 4; ++k) { g0[k] = (float)((gw[i].x >> (8 * k)) & 0xffu) * (1.0f / 255.0f); g1[k] = (float)((gw[i].y >> (8 * k)) & 0xffu) * (1.0f / 255.0f); }
            f32x4 v0 = acc[ai][bj][m][0] * g0, v1 = acc[ai][bj][m][1] * g1;
            if (!first) { f32x4 p0, p1; unpack8(pv[i], p0, p1); v0 += p0; v1 += p1; }
            *(u32x4*)(mp + (size_t)PROJ_OFF(i) * DM + bj * HALF) = pack8(v0, v1);
            __builtin_amdgcn_sched_barrier(0); }
#undef PROJ_OFF
#undef PROJ_LD_
    }
};
struct EpiProj2 {
    static constexpr bool PERM = true;
    struct Early { u32x2 ga[4], gb[4]; }; static constexpr int NEARLY = 8;
    const unsigned char* gate; bf16_t* merged;
    __device__ __forceinline__ void pre(const Unit&, SpP, int, int) const {}
    __device__ __forceinline__ void early(const Unit& u, int wr, int wc, int fr, int fq, Early& ev) const {
        const unsigned char* gp = gate + (size_t)(u.pm * HALF + wr * 64 + fr) * GATE_LD + u.pn * BM + wc * 32 + 8 * fq;
#pragma unroll
        for (int i = 0; i < 4; ++i) { const size_t ro = (size_t)((i & 3) * 16) * GATE_LD + (i >> 2) * HALF; ev.ga[i] = *(const u32x2*)(gp + ro); ev.gb[i] = *(const u32x2*)(gp + ro + DM); }
    }
    __device__ __forceinline__ void with_early(const Acc& acc, const Unit& u, int wr, int wc, int fr, int fq, SpP, const Early& ev) const {
        const int row0 = u.pm * HALF + wr * 64 + fr, colt = u.pn * BM + wc * 32 + 8 * fq;
        bf16_t* mp = merged + (size_t)row0 * DM + colt; const unsigned char* gp = gate + (size_t)row0 * GATE_LD + colt;
        u32x2 ga[8], gb[8];
#pragma unroll
        for (int i = 0; i < 4; ++i) { ga[i] = ev.ga[i]; gb[i] = ev.gb[i]; }
#pragma unroll
        for (int i = 4; i < 8; ++i) { const size_t ro = (size_t)((i & 3) * 16) * GATE_LD + (i >> 2) * HALF; ga[i] = *(const u32x2*)(gp + ro); gb[i] = *(const u32x2*)(gp + ro + DM); }
#pragma unroll
        for (int i = 0; i < 8; ++i) { const int bj = i >> 2, m = i & 3; f32x4 a0, a1, b0, b1;
#pragma unroll
            for (int k = 0; k < 4; ++k) { a0[k] = (float)((ga[i].x >> (8 * k)) & 0xffu) * (1.0f / 255.0f); a1[k] = (float)((ga[i].y >> (8 * k)) & 0xffu) * (1.0f / 255.0f);
                                          b0[k] = (float)((gb[i].x >> (8 * k)) & 0xffu) * (1.0f / 255.0f); b1[k] = (float)((gb[i].y >> (8 * k)) & 0xffu) * (1.0f / 255.0f); }
            const f32x4 v0 = acc[0][bj][m][0] * a0 + acc[1][bj][m][0] * b0, v1 = acc[0][bj][m][1] * a1 + acc[1][bj][m][1] * b1;
            *(u32x4*)(mp + (size_t)(m * 16) * DM + bj * HALF) = pack8(v0, v1); }
    }
    __device__ __forceinline__ void operator()(const Acc& acc, const Unit& u, int wr, int wc, int fr, int fq, SpP sp) const { Early ev; early(u, wr, wc, fr, fq, ev); with_early(acc, u, wr, wc, fr, fq, sp, ev); }
};
struct EpiWoutF {
    static constexpr bool PERM = true;
    const float* x; bf16_t* x1; const float* g2; unsigned* amax;
    struct Early { f32x4 r0[4]; }; static constexpr int NEARLY = 4;
    __device__ __forceinline__ void pre(const Unit&, SpP, int, int) const {}
    __device__ __forceinline__ void early(const Unit& u, int wr, int wc, int fr, int fq, Early& ev) const {
        const float* xp = x + (size_t)(u.pm * BM + wr * 64 + fr) * DM + u.pn * BM + wc * 32 + 8 * fq;
        ev.r0[0] = *(const f32x4*)xp; ev.r0[1] = *(const f32x4*)(xp + 4); ev.r0[2] = *(const f32x4*)(xp + HALF); ev.r0[3] = *(const f32x4*)(xp + HALF + 4);
    }
    __device__ __forceinline__ void operator()(const Acc& acc, const Unit& u, int wr, int wc, int fr, int fq, SpP sp) const { Early ev; early(u, wr, wc, fr, fq, ev); with_early(acc, u, wr, wc, fr, fq, sp, ev); }
    __device__ __forceinline__ void with_early(const Acc& acc, const Unit& u, int wr, int wc, int fr, int fq, SpP, const Early& ev) const {
        const int row0 = u.pm * BM + wr * 64 + fr, colt = u.pn * BM + wc * 32 + 8 * fq;
        f32x4 gg[2][2];
#pragma unroll
        for (int bj = 0; bj < 2; ++bj)
#pragma unroll
            for (int n = 0; n < 2; ++n) gg[bj][n] = *(const f32x4*)(g2 + colt + bj * HALF + n * 4);
        f32x4 xb[8][4];
#define WOUT_LD(r) do { const float* xp_ = x + (size_t)(row0 + ((r) >> 2) * HALF + ((r) & 3) * 16) * DM + colt; xb[r][0] = *(const f32x4*)xp_; xb[r][1] = *(const f32x4*)(xp_ + 4); xb[r][2] = *(const f32x4*)(xp_ + HALF); xb[r][3] = *(const f32x4*)(xp_ + HALF + 4); } while (0)
#pragma unroll
        for (int j = 0; j < 4; ++j) xb[0][j] = ev.r0[j];
        WOUT_LD(1);
#pragma unroll
        for (int r = 0; r < 8; ++r) { if (r + 2 < 8) WOUT_LD(r + 2);
            __builtin_amdgcn_sched_barrier(0);
            const int ai = r >> 2, m = r & 3; const int row = row0 + ai * HALF + m * 16; float am = 0.f;
#pragma unroll
            for (int bj = 0; bj < 2; ++bj) { const u32x4 pk = pack8(xb[r][2 * bj] + acc[ai][bj][m][0], xb[r][2 * bj + 1] + acc[ai][bj][m][1]);
                *(u32x4*)(x1 + (size_t)row * DM + colt + bj * HALF) = pk;
                f32x4 r0, r1; unpack8(pk, r0, r1); const f32x4 h0 = r0 * gg[bj][0], h1 = r1 * gg[bj][1];
                am = __builtin_fmaxf(am, __builtin_fmaxf(__builtin_fmaxf(__builtin_fabsf(h0[0]), __builtin_fabsf(h0[1])), __builtin_fmaxf(__builtin_fabsf(h0[2]), __builtin_fabsf(h0[3]))));
                am = __builtin_fmaxf(am, __builtin_fmaxf(__builtin_fmaxf(__builtin_fabsf(h1[0]), __builtin_fabsf(h1[1])), __builtin_fmaxf(__builtin_fabsf(h1[2]), __builtin_fabsf(h1[3])))); }
            am = __builtin_fmaxf(am, __shfl_xor(am, 16)); am = __builtin_fmaxf(am, __shfl_xor(am, 32));
            if (fq == 0) atomicMax(amax + row, __float_as_uint(am));
            __builtin_amdgcn_sched_barrier(0); }
#undef WOUT_LD
    }
};
struct EpiMoe1F {
    static constexpr bool PERM = true;
    bf16_t* act; const float* b1; const int* stok; const float* rnorm; int tile0; int pad_;
    __device__ __forceinline__ void operator()(const Acc& acc, const Unit& u, int wr, int wc, int fr, int fq) const {
        const int row0 = (u.pm - tile0) * BM + wr * 64 + fr, c = u.pn * HALF + wc * 32 + 8 * fq;
        const float* bg = b1 + (size_t)u.e * 2048 + c; const f32x4 bg0 = *(const f32x4*)bg, bg1 = *(const f32x4*)(bg + 4), bl0 = *(const f32x4*)(bg + 1024), bl1 = *(const f32x4*)(bg + 1028);
#pragma unroll
        for (int ai = 0; ai < 2; ++ai)
#pragma unroll
            for (int m = 0; m < 4; ++m) { f32x4 o0, o1; const int tk = stok[u.pm * BM + wr * 64 + fr + ai * HALF + m * 16]; const float rs = tk >= 0 ? rnorm[tk] : 0.f;
#pragma unroll
                for (int k = 0; k < 4; ++k) {
                    { const float glu = fminf(acc[ai][0][m][0][k] * rs + bg0[k], 7.0f), lin = fminf(fmaxf(acc[ai][1][m][0][k] * rs + bl0[k], -7.0f), 7.0f); o0[k] = glu * sigmoidf_(1.702f * glu) * (lin + 1.0f); }
                    { const float glu = fminf(acc[ai][0][m][1][k] * rs + bg1[k], 7.0f), lin = fminf(fmaxf(acc[ai][1][m][1][k] * rs + bl1[k], -7.0f), 7.0f); o1[k] = glu * sigmoidf_(1.702f * glu) * (lin + 1.0f); } }
                *(u32x4*)(act + (size_t)(row0 + ai * HALF + m * 16) * DM + c) = pack8(o0, o1); }
    }
};
struct EpiMoe1I {
    struct Early {}; static constexpr int NEARLY = 0; __device__ __forceinline__ void early(const Unit&, int, int, int, int, Early&) const {}
    static constexpr bool PERM = true;
    bf16_t* act; const float* b1; const float* rss; const float* sw1; int tile0; int pad_;
    __device__ __forceinline__ void pre(const Unit& u, SpP sp, int wid, int lane) const {
        if (wid == 0) dma1k(rss + u.pm * BM + 4 * lane, sp); else if (wid == 1) dma1k(sw1 + (size_t)u.e * 2048 + u.pn * BM + 4 * lane, sp + 1024);
        else if (wid == 2) dma1k(b1 + (size_t)u.e * 2048 + (lane >> 5) * 1024 + u.pn * HALF + 4 * (lane & 31), sp + 2048);
    }
    __device__ __forceinline__ void operator()(const i32x4 (&acc)[2][2][4][2], const Unit& u, int wr, int wc, int fr, int fq, SpP sp) const {
        const int row0 = (u.pm - tile0) * BM + wr * 64 + fr, c = u.pn * HALF + wc * 32 + 8 * fq, cl = (wc * 32 + 8 * fq) * 4;
        const f32x4 bg0 = *(const PG8_LAS f32x4*)(sp + 2048 + cl), bg1 = *(const PG8_LAS f32x4*)(sp + 2048 + cl + 16), bl0 = *(const PG8_LAS f32x4*)(sp + 2560 + cl), bl1 = *(const PG8_LAS f32x4*)(sp + 2560 + cl + 16);
        const f32x4 sg0 = *(const PG8_LAS f32x4*)(sp + 1024 + cl), sg1 = *(const PG8_LAS f32x4*)(sp + 1024 + cl + 16), sl0 = *(const PG8_LAS f32x4*)(sp + 1536 + cl), sl1 = *(const PG8_LAS f32x4*)(sp + 1536 + cl + 16);
#pragma unroll
        for (int ai = 0; ai < 2; ++ai)
#pragma unroll
            for (int m = 0; m < 4; ++m) { f32x4 o0, o1; const float rs = *(const PG8_LAS float*)(sp + (wr * 64 + fr + ai * HALF + m * 16) * 4);
#pragma unroll
                for (int k = 0; k < 4; ++k) {
                    { const float glu = fminf((float)acc[ai][0][m][0][k] * (rs * sg0[k]) + bg0[k], 7.0f), lin = fminf(fmaxf((float)acc[ai][1][m][0][k] * (rs * sl0[k]) + bl0[k], -7.0f), 7.0f); o0[k] = glu * sigmoidf_(1.702f * glu) * __builtin_fmaf(lin, 4.0f, 4.0f); }
                    { const float glu = fminf((float)acc[ai][0][m][1][k] * (rs * sg1[k]) + bg1[k], 7.0f), lin = fminf(fmaxf((float)acc[ai][1][m][1][k] * (rs * sl1[k]) + bl1[k], -7.0f), 7.0f); o1[k] = glu * sigmoidf_(1.702f * glu) * __builtin_fmaf(lin, 4.0f, 4.0f); } }
                unsigned w0 = __builtin_amdgcn_cvt_pk_fp8_f32(o0[0], o0[1], 0, false); w0 = __builtin_amdgcn_cvt_pk_fp8_f32(o0[2], o0[3], w0, true);
                unsigned w1 = __builtin_amdgcn_cvt_pk_fp8_f32(o1[0], o1[1], 0, false); w1 = __builtin_amdgcn_cvt_pk_fp8_f32(o1[2], o1[3], w1, true);
                u32x2 w; w.x = w0; w.y = w1; *(u32x2*)((unsigned char*)act + (size_t)(row0 + ai * HALF + m * 16) * DM + c) = w; }
    }
};
struct EpiMoe2F {
    struct Early {}; static constexpr int NEARLY = 0; __device__ __forceinline__ void early(const Unit&, int, int, int, int, Early&) const {}
    static constexpr bool PERM = true;
    bf16_t* y; const float* b2; const int* rdst; const float* rgate; const float* sw2;
    __device__ __forceinline__ void pre(const Unit& u, SpP sp, int wid, int lane) const {
        if (wid == 0) dma1k(rdst + u.pm * BM + 4 * lane, sp); else if (wid == 1) dma1k(rgate + u.pm * BM + 4 * lane, sp + 1024);
        else if (wid == 2) dma1k(b2 + (size_t)u.e * DM + u.pn * BM + 4 * lane, sp + 2048); else if (wid == 3) dma1k(sw2 + (size_t)u.e * DM + u.pn * BM + 4 * lane, sp + 3072);
    }
    __device__ __forceinline__ void operator()(const Acc& acc, const Unit& u, int wr, int wc, int fr, int fq, SpP sp) const {
        const int colt = u.pn * BM + wc * 32 + 8 * fq, cl = (wc * 32 + 8 * fq) * 4;
        f32x4 cs_[2][2], cb_[2][2];
#pragma unroll
        for (int bj = 0; bj < 2; ++bj) { const PG8_LAS f32x4* bp = (const PG8_LAS f32x4*)(sp + 2048 + bj * 512 + cl); const PG8_LAS f32x4* sq = (const PG8_LAS f32x4*)(sp + 3072 + bj * 512 + cl);
            cs_[bj][0] = sq[0] * 0.25f; cs_[bj][1] = sq[1] * 0.25f; cb_[bj][0] = bp[0]; cb_[bj][1] = bp[1]; }
#pragma unroll
        for (int ai = 0; ai < 2; ++ai)
#pragma unroll
            for (int m = 0; m < 4; ++m) { const int lr = (wr * 64 + fr + ai * HALF + m * 16) * 4; const int dst = *(const PG8_LAS int*)(sp + lr); if (dst < 0) continue; const float gt8 = *(const PG8_LAS float*)(sp + 1024 + lr) * 8.0f;
#pragma unroll
                for (int bj = 0; bj < 2; ++bj) { const int col = colt + bj * HALF;
                    f32x4 y0 = (acc[ai][bj][m][0] * cs_[bj][0] + cb_[bj][0]) * gt8, y1 = (acc[ai][bj][m][1] * cs_[bj][1] + cb_[bj][1]) * gt8;
#pragma unroll
                    for (int k = 0; k < 4; ++k) { y0[k] = __builtin_amdgcn_fmed3f(y0[k], -448.f, 448.f); y1[k] = __builtin_amdgcn_fmed3f(y1[k], -448.f, 448.f); }
                    unsigned w0 = __builtin_amdgcn_cvt_pk_fp8_f32(y0[0], y0[1], 0, false); w0 = __builtin_amdgcn_cvt_pk_fp8_f32(y0[2], y0[3], w0, true);
                    unsigned w1 = __builtin_amdgcn_cvt_pk_fp8_f32(y1[0], y1[1], 0, false); w1 = __builtin_amdgcn_cvt_pk_fp8_f32(y1[2], y1[3], w1, true);
                    u32x2 w; w.x = w0; w.y = w1; *(u32x2*)((unsigned char*)y + (size_t)dst * DM + col) = w; } }
    }
};
}

struct Params {
    const float *x, *norm1_g, *w_in, *w_proj_a, *w_proj_b, *w_gate, *b_gate, *w_out, *norm2_g, *w_router, *b_router, *w1, *b1, *w2, *b2, *norm_f_g;
    float* out; char* ws; RopeF fr;
};

__device__ __forceinline__ void p0_transpose_item(const float* __restrict__ W, int K, int N, bf16_t* __restrict__ WT, int ldt  , LAS float* scr, int item, int lane) {
    const int nblk = N / 32, kb = item / nblk, nb = item % nblk, k0 = 64 * kb, n0 = 32 * nb;
#pragma unroll 8
    for (int i = 0; i < 32; ++i) { const int kk = 2 * i + (lane >> 5); scr[kk * 33 + (lane & 31)] = W[(size_t)(k0 + kk) * N + n0 + (lane & 31)]; }
    WAVE_FENCE();
    const int c = lane & 7;
#pragma unroll
    for (int j = 0; j < 4; ++j) { const int n = (lane >> 3) + 8 * j; const LAS float* sp = scr + (8 * c) * 33 + n;
        u32x4 o; o.x = cvtpk(sp[0 * 33], sp[1 * 33]); o.y = cvtpk(sp[2 * 33], sp[3 * 33]); o.z = cvtpk(sp[4 * 33], sp[5 * 33]); o.w = cvtpk(sp[6 * 33], sp[7 * 33]);
        *(u32x4*)(WT + (size_t)(n0 + n) * ldt + k0 + 8 * c) = o; }
    WAVE_FENCE();
}

template <int F8>
__device__ __forceinline__ void p0_quant_item(const float* __restrict__ W, int N, signed char* __restrict__ Wq, float* __restrict__ sw, int mode, int n0, LAS char* scr, int lane) {
    constexpr float QMAX = F8 ? 448.0f : 127.0f;
    const int n4 = lane & 7, kr = lane >> 3; const float* wp = W + (size_t)kr * N + n0 + 4 * n4;
    f32x4 mx = (f32x4){0.f, 0.f, 0.f, 0.f};
#pragma unroll 8
    for (int i = 0; i < 128; ++i) { const f32x4 v = *(const f32x4*)(wp + (size_t)(8 * i) * N);
#pragma unroll
        for (int j = 0; j < 4; ++j) mx[j] = __builtin_fmaxf(mx[j], __builtin_fabsf(v[j])); }
#pragma unroll
    for (int o = 8; o < 64; o <<= 1)
#pragma unroll
        for (int j = 0; j < 4; ++j) mx[j] = __builtin_fmaxf(mx[j], __shfl_xor(mx[j], o));
    f32x4 qs;
#pragma unroll
    for (int j = 0; j < 4; ++j) qs[j] = mx[j] > 0.f ? QMAX / mx[j] : 0.f;
    const int npb = mode ? w1map(n0) : n0;
    if (kr == 0) *(f32x4*)(sw + npb + 4 * n4) = mx * (1.0f / QMAX);
#pragma unroll 1
    for (int c = 0; c < 8; ++c) {
        WAVE_FENCE();
#pragma unroll 4
        for (int i = 0; i < 16; ++i) { const f32x4 v = *(const f32x4*)(wp + (size_t)(128 * c + 8 * i) * N);
#pragma unroll
            for (int j = 0; j < 4; ++j) { const float t = v[j] * qs[j];
                *(LAS signed char*)(scr + (4 * n4 + j) * 144 + 8 * i + kr) = F8 ? (signed char)(__builtin_amdgcn_cvt_pk_fp8_f32(t, t, 0, false) & 0xff) : (signed char)(int)__builtin_rintf(t); } }
        WAVE_FENCE();
#pragma unroll
        for (int t = 0; t < 4; ++t) { const int id = lane + 64 * t, row = id >> 3, ch = id & 7;
            *(u32x4*)(Wq + (size_t)(npb + row) * 1024 + 128 * c + 16 * ch) = *(const LAS u32x4*)(scr + row * 144 + ch * 16); }
    }
    WAVE_FENCE();
}

template <int F8>
__device__ __forceinline__ void p0_quant_block(const float* __restrict__ W, int N, signed char* __restrict__ Wq, float* __restrict__ sw, int mode, int n0, LAS char* scr, LAS float* xch, int wid, int lane, float ssc = 1.0f  ) {
    constexpr float QMAX = F8 ? 448.0f : 127.0f;
    const int n4 = lane & 7, kr = lane >> 3; const float* wp = W + (size_t)(128 * wid + kr) * N + n0 + 4 * n4;
    f32x4 v[16]; f32x4 mx = (f32x4){0.f, 0.f, 0.f, 0.f};
#pragma unroll
    for (int i = 0; i < 16; ++i) v[i] = *(const f32x4*)(wp + (size_t)(8 * i) * N);
#pragma unroll
    for (int i = 0; i < 16; ++i)
#pragma unroll
        for (int j = 0; j < 4; ++j) mx[j] = __builtin_fmaxf(mx[j], __builtin_fabsf(v[i][j]));
#pragma unroll
    for (int o = 8; o < 64; o <<= 1)
#pragma unroll
        for (int j = 0; j < 4; ++j) mx[j] = __builtin_fmaxf(mx[j], __shfl_xor(mx[j], o));
    if (kr == 0) *(LAS f32x4*)(xch + wid * 32 + 4 * n4) = mx;
    __syncthreads();
#pragma unroll
    for (int w = 0; w < 8; ++w) { const f32x4 o = *(const LAS f32x4*)(xch + w * 32 + 4 * n4);
#pragma unroll
        for (int j = 0; j < 4; ++j) mx[j] = __builtin_fmaxf(mx[j], o[j]); }
    f32x4 qs;
#pragma unroll
    for (int j = 0; j < 4; ++j) qs[j] = mx[j] > 0.f ? QMAX / mx[j] : 0.f;
    const int npb = mode ? w1map(n0) : n0;
    if (wid == 0 && kr == 0) *(f32x4*)(sw + npb + 4 * n4) = mx * ((1.0f / QMAX) * ssc);
    WAVE_FENCE();
#pragma unroll
    for (int i = 0; i < 16; ++i)
#pragma unroll
        for (int j = 0; j < 4; ++j) { const float t = v[i][j] * qs[j];
            *(LAS signed char*)(scr + (4 * n4 + j) * 144 + 8 * i + kr) = F8 ? (signed char)(__builtin_amdgcn_cvt_pk_fp8_f32(t, t, 0, false) & 0xff) : (signed char)(int)__builtin_rintf(t); }
    WAVE_FENCE();
#pragma unroll
    for (int t = 0; t < 4; ++t) { const int id = lane + 64 * t, row = id >> 3, ch = id & 7;
        *(u32x4*)(Wq + (size_t)(npb + row) * 1024 + 128 * wid + 16 * ch) = *(const LAS u32x4*)(scr + row * 144 + ch * 16); }
    __syncthreads();
}
__device__ __forceinline__ void phase_p0(const Params& p, char* ws) {
    int tidx = threadIdx.x; asm volatile("" : "+v"(tidx));
    const int wid = __builtin_amdgcn_readfirstlane(tidx >> 6), lane = tidx & 63;
    LAS float* scr = (LAS float*)((LAS char*)dyn_lds + 1024 + wid * 16384);
    const int gw = (int)blockIdx.x * 8 + wid, NGW = (int)gridDim.x * 8;
    bf16_t* Win = (bf16_t*)(ws + WS_WIN); bf16_t* PA = (bf16_t*)(ws + WS_PA); bf16_t* PB = (bf16_t*)(ws + WS_PB); bf16_t* Wout = (bf16_t*)(ws + WS_WOUT);
    bf16_t* W1 = (bf16_t*)(ws + WS_W1); bf16_t* W2 = (bf16_t*)(ws + WS_W2);
    signed char* Winq = (signed char*)(ws + WS_WIN); float* swin = (float*)(ws + WS_SWIN);
    LAS float* xch = (LAS float*)((LAS char*)dyn_lds + 1024 + 8 * 16384);
    constexpr int B_W1 = NE * 64, B_W2 = NE * 32, B_IN = 96, B_G = 64, NBLK = B_W1 + B_W2 + B_IN + B_G;
    for (int bk = (int)blockIdx.x; bk < NBLK; bk += (int)gridDim.x) {
        int r = bk;
        if (r < B_W1) { const int e = r >> 6; p0_quant_block<0>(p.w1 + (size_t)e * 1024 * 2048, 2048, (signed char*)W1 + (size_t)e * 2048 * 1024, (float*)(ws + WS_SW1) + e * 2048, 1, 32 * (r & 63), (LAS char*)scr, xch, wid, lane); continue; } r -= B_W1;
        if (r < B_W2) { const int e = r >> 5; p0_quant_block<1>(p.w2 + (size_t)e * 1024 * 1024, 1024, (signed char*)W2 + (size_t)e * 1024 * 1024, (float*)(ws + WS_SW2) + e * 1024, 0, 32 * (r & 31), (LAS char*)scr, xch, wid, lane); continue; } r -= B_W2;
        if (r < B_IN) { const int n0 = 32 * r;
            p0_quant_block<0>(p.w_in, 3072, Winq, swin, 0, n0, (LAS char*)scr, xch, wid, lane, (n0 < 512 || (n0 >= 1536 && n0 < 2048)) ? C2LOG : 1.0f); continue; } r -= B_IN;
        p0_quant_block<0>(p.w_gate, 2048, Winq + (size_t)3072 * 1024, swin + 3072, 0, 32 * r, (LAS char*)scr, xch, wid, lane);
    }
    constexpr int I_P = 8 * 32, I_O = 16 * 32, NITEMS = 2 * I_P + I_O;
    for (int it = gw; it < NITEMS; it += NGW) {
        int r = it;
        if (r < I_P) { p0_transpose_item(p.w_proj_a, 512, 1024, PA, 1024, scr, r, lane); continue; } r -= I_P;
        if (r < I_P) { p0_transpose_item(p.w_proj_b, 512, 1024, PA + 512, 1024, scr, r, lane); continue; } r -= I_P;
        p0_transpose_item(p.w_out, 1024, 1024, Wout, 1024, scr, r, lane);
    }
    { int* stok_ = (int*)(ws + WS_STOK); int* rdst_ = (int*)(ws + WS_RDST); float* rss_ = (float*)(ws + WS_RSS); unsigned* amax_ = (unsigned*)(ws + WS_AMAX);
      for (int i = (int)blockIdx.x * 512 + tidx; i < MAXROWS; i += (int)gridDim.x * 512) { stok_[i] = -1; rdst_[i] = -1; rss_[i] = 0.f; }
      for (int i = (int)blockIdx.x * 512 + tidx; i < NTOK; i += (int)gridDim.x * 512) amax_[i] = 0u; }
    float* rope = (float*)(ws + WS_ROPE);
    for (int i = (int)blockIdx.x * 512 + tidx; i < SEQ * 8; i += (int)gridDim.x * 512) { const int pos = i >> 3, j = i & 7;
        const float fj = j == 0 ? p.fr.f[0] : j == 1 ? p.fr.f[1] : j == 2 ? p.fr.f[2] : j == 3 ? p.fr.f[3] : j == 4 ? p.fr.f[4] : j == 5 ? p.fr.f[5] : j == 6 ? p.fr.f[6] : p.fr.f[7];
        float sn, cs; sincosf((float)pos * fj, &sn, &cs); rope[i] = cs; rope[SEQ * 8 + i] = sn; }
    signed char* XNq = (signed char*)(ws + WS_XN); float* sx = (float*)(ws + WS_SX);
    for (int row0 = gw; row0 < NTOK; row0 += 2 * NGW) {
        f32x4 v[2][4];
#pragma unroll
        for (int q = 0; q < 2; ++q) { const f32x4* xr = (const f32x4*)(p.x + (size_t)(row0 + q * NGW) * DM) + lane;
#pragma unroll
            for (int i = 0; i < 4; ++i) v[q][i] = xr[64 * i]; }
#pragma unroll
        for (int q = 0; q < 2; ++q) { const int row = row0 + q * NGW; float ss = 0.f;
#pragma unroll
            for (int i = 0; i < 4; ++i) ss += (v[q][i][0] * v[q][i][0] + v[q][i][1] * v[q][i][1]) + (v[q][i][2] * v[q][i][2] + v[q][i][3] * v[q][i][3]);
            ss = wave_sum(ss); const float rn = rsqrtf(ss * (1.0f / DM) + 1e-5f); float am = 0.f;
#pragma unroll
            for (int i = 0; i < 4; ++i) { const f32x4 gg = ((const f32x4*)p.norm1_g)[lane + 64 * i]; v[q][i] = v[q][i] * rn * gg;
                am = __builtin_fmaxf(am, __builtin_fmaxf(__builtin_fmaxf(__builtin_fabsf(v[q][i][0]), __builtin_fabsf(v[q][i][1])), __builtin_fmaxf(__builtin_fabsf(v[q][i][2]), __builtin_fabsf(v[q][i][3])))); }
            am = wave_max(am); const float qs = am > 0.f ? 127.0f / am : 0.f;
            if (lane == 0) sx[row] = am * (1.0f / 127.0f);
#pragma unroll
            for (int i = 0; i < 4; ++i) { const unsigned w = ((unsigned)(int)__builtin_rintf(v[q][i][0] * qs) & 0xffu) | (((unsigned)(int)__builtin_rintf(v[q][i][1] * qs) & 0xffu) << 8)
                    | (((unsigned)(int)__builtin_rintf(v[q][i][2] * qs) & 0xffu) << 16) | (((unsigned)(int)__builtin_rintf(v[q][i][3] * qs) & 0xffu) << 24);
                *(unsigned*)(XNq + (size_t)row * DM + 4 * (lane + 64 * i)) = w; } }
    }
}
constexpr int RT_PITCH = 2064;
constexpr int RT_WG = 1024, RT_WM = RT_WG + 32 * RT_PITCH, RT_G2 = RT_WM + 32 * RT_PITCH, RT_HIST = RT_G2 + 4096;
__device__ __forceinline__ bool rt_better(float av, int ai, float bv, int bi) { return av > bv || (av == bv && ai < bi); }
__device__ __forceinline__ void phase_router(const bf16_t* __restrict__ x1, const float* __restrict__ g2, const float* __restrict__ wr, const float* __restrict__ br,
                                             signed char* __restrict__ h2, const unsigned* __restrict__ amax, int* __restrict__ toke, float* __restrict__ tokg, float* __restrict__ rnorm, int* __restrict__ cnt) {
    int tidx = threadIdx.x; asm volatile("" : "+v"(tidx));
    const int wid = __builtin_amdgcn_readfirstlane(tidx >> 6), lane = tidx & 63, r32 = lane & 31, hi = lane >> 5;
    LAS char* Wh = (LAS char*)dyn_lds + RT_WG; LAS char* Wm = (LAS char*)dyn_lds + RT_WM; LAS float* G2 = (LAS float*)((LAS char*)dyn_lds + RT_G2); LAS int* hist = (LAS int*)((LAS char*)dyn_lds + RT_HIST);
    for (int it = tidx; it < 4096; it += 512) { const int e = it & 31, kb = it >> 5; u32x4 ph, pm;
#pragma unroll
        for (int j = 0; j < 4; ++j) { const int k = 8 * kb + 2 * j; const float w0 = wr[k * 32 + e] * g2[k], w1 = wr[(k + 1) * 32 + e] * g2[k + 1];
            const unsigned h = cvtpk(w0, w1); const float r0 = w0 - bf2f(h & 0xffff), r1 = w1 - bf2f(h >> 16); ph[j] = h; pm[j] = cvtpk(r0, r1); }
        *(LAS u32x4*)(Wh + e * RT_PITCH + kb * 16) = ph; *(LAS u32x4*)(Wm + e * RT_PITCH + kb * 16) = pm; }
    for (int i = tidx; i < 1024; i += 512) G2[i] = g2[i];
    if (tidx < 32) hist[tidx] = 0;
    __syncthreads();
    for (int wt = (int)blockIdx.x * 8 + wid; wt < NTOK / 32; wt += (int)gridDim.x * 8) {
        const int tok = wt * 32 + r32;
        const bf16_t* xr = x1 + (size_t)tok * DM + 8 * hi; signed char* hr = h2 + (size_t)tok * DM + 8 * hi;
        const float am = __uint_as_float(amax[tok]), qs = am > 0.f ? 127.0f / am : 0.f;
        f32x16 acc;
#pragma unroll
        for (int r = 0; r < 16; ++r) acc[r] = 0.f;
        float ss = 0.f;
        u32x4 xw[2][8];
#pragma unroll
        for (int j = 0; j < 8; ++j) xw[0][j] = *(const u32x4*)(xr + 16 * j);
#pragma unroll
        for (int c = 0; c < 8; ++c) {
            if (c + 1 < 8) {
#pragma unroll
                for (int j = 0; j < 8; ++j) xw[(c + 1) & 1][j] = *(const u32x4*)(xr + 16 * (8 * (c + 1) + j)); }
            __builtin_amdgcn_sched_barrier(0);
#pragma unroll
            for (int j = 0; j < 8; ++j) { const int q = 8 * c + j;
                f32x4 xa, xb; pg8::unpack8(xw[c & 1][j], xa, xb);
                const f32x4 ga = *(const LAS f32x4*)(G2 + 16 * q + 8 * hi), gb = *(const LAS f32x4*)(G2 + 16 * q + 8 * hi + 4);
                ss += (xa[0] * xa[0] + xa[1] * xa[1]) + (xa[2] * xa[2] + xa[3] * xa[3]) + (xb[0] * xb[0] + xb[1] * xb[1]) + (xb[2] * xb[2] + xb[3] * xb[3]);
                const f32x4 ha = xa * ga, hb = xb * gb;
                u32x2 w;
                w.x = ((unsigned)(int)__builtin_rintf(ha[0] * qs) & 0xffu) | (((unsigned)(int)__builtin_rintf(ha[1] * qs) & 0xffu) << 8) | (((unsigned)(int)__builtin_rintf(ha[2] * qs) & 0xffu) << 16) | (((unsigned)(int)__builtin_rintf(ha[3] * qs) & 0xffu) << 24);
                w.y = ((unsigned)(int)__builtin_rintf(hb[0] * qs) & 0xffu) | (((unsigned)(int)__builtin_rintf(hb[1] * qs) & 0xffu) << 8) | (((unsigned)(int)__builtin_rintf(hb[2] * qs) & 0xffu) << 16) | (((unsigned)(int)__builtin_rintf(hb[3] * qs) & 0xffu) << 24);
                *(u32x2*)(hr + 16 * q) = w;
                const bf16x8 xf = __builtin_bit_cast(bf16x8, xw[c & 1][j]);
                const bf16x8 wh = *(const LAS bf16x8*)(Wh + r32 * RT_PITCH + (16 * q + 8 * hi) * 2), wm = *(const LAS bf16x8*)(Wm + r32 * RT_PITCH + (16 * q + 8 * hi) * 2);
                acc = MFMA32(wh, xf, acc); acc = MFMA32(wm, xf, acc);
            }
            __builtin_amdgcn_sched_barrier(0);
        }
        ss += __shfl_xor(ss, 32);
        const float rn = rsqrtf(ss * (1.0f / DM) + 1e-5f);
        float lg[16];
#pragma unroll
        for (int r = 0; r < 16; ++r) lg[r] = acc[r] * rn + br[crow(r, hi)];
        float tv[4]; int te[4];
#pragma unroll
        for (int k = 0; k < 4; ++k) { float bv = -INFINITY; int bi = 64;
#pragma unroll
            for (int r = 0; r < 16; ++r) { const int e = crow(r, hi); if (rt_better(lg[r], e, bv, bi)) { bv = lg[r]; bi = e; } }
            tv[k] = bv; te[k] = bi;
#pragma unroll
            for (int r = 0; r < 16; ++r) if (crow(r, hi) == bi) lg[r] = -INFINITY; }
        float pv[4]; int pe[4];
#pragma unroll
        for (int k = 0; k < 4; ++k) { pv[k] = __shfl_xor(tv[k], 32); pe[k] = __shfl_xor(te[k], 32); }
        float cv[8] = {tv[0], tv[1], tv[2], tv[3], pv[0], pv[1], pv[2], pv[3]}; int ce[8] = {te[0], te[1], te[2], te[3], pe[0], pe[1], pe[2], pe[3]};
        float fv[4]; int fe[4];
#pragma unroll
        for (int k = 0; k < 4; ++k) { float bv = -INFINITY; int bi = 64;
#pragma unroll
            for (int j = 0; j < 8; ++j) if (rt_better(cv[j], ce[j], bv, bi)) { bv = cv[j]; bi = ce[j]; }
            fv[k] = bv; fe[k] = bi;
#pragma unroll
            for (int j = 0; j < 8; ++j) if (ce[j] == bi) cv[j] = -INFINITY; }
        if (hi == 0) {
            const float e1 = __expf(fv[1] - fv[0]), e2 = __expf(fv[2] - fv[0]), e3 = __expf(fv[3] - fv[0]), inv = 1.0f / (1.0f + e1 + e2 + e3);
            *(int4*)(toke + (size_t)tok * 4) = make_int4(fe[0], fe[1], fe[2], fe[3]); *(float4*)(tokg + (size_t)tok * 4) = make_float4(inv, e1 * inv, e2 * inv, e3 * inv);
            rnorm[tok] = rn * am * (1.0f / 127.0f);
#pragma unroll
            for (int k = 0; k < 4; ++k) (void)__hip_atomic_fetch_add(hist + fe[k], 1, __ATOMIC_RELAXED, __HIP_MEMORY_SCOPE_WORKGROUP);
        }
    }
    __syncthreads();
    if (tidx < 32) atomicAdd(cnt + tidx, (int)hist[tidx]);
}
__device__ __forceinline__ void phase_assign(const int* __restrict__ toke, const float* __restrict__ tokg, const float* __restrict__ rnorm, int* ctrl, int* stok, int* rdst, float* rgate, float* rss) {
    int tidx = threadIdx.x; asm volatile("" : "+v"(tidx));
    LAS int* lcnt = (LAS int*)((LAS char*)dyn_lds + 1024); LAS int* lbase = lcnt + 32; LAS int* lps = lcnt + 64;
    if (tidx < 32) lcnt[tidx] = 0;
    if (tidx == 0) { int ps = 0; for (int e = 0; e < NE; ++e) { lps[e] = ps; ps += ((ctrl[C_CNT + e] + 255) >> 8) << 8; } lps[NE] = ps; }
    __syncthreads();
    if (blockIdx.x == 0) {
        const int ntl = lps[NE] >> 8;
        for (int t = tidx; t < ntl; t += 512) { int e = 0;
#pragma unroll 1
            for (int j = 1; j < NE; ++j) if (lps[j] <= t * 256) e = j;
            ctrl[C_TILEE + t] = e; }
        if (tidx == 0) ctrl[C_NTILES] = ntl;
    }
    for (int base = (int)blockIdx.x * 1024; base < NSLOT; base += (int)gridDim.x * 1024) {
        const int i0 = base + tidx, i1 = base + 512 + tidx;
        const int e0 = toke[i0], e1 = toke[i1];
        const int r0 = __hip_atomic_fetch_add(lcnt + e0, 1, __ATOMIC_RELAXED, __HIP_MEMORY_SCOPE_WORKGROUP), r1 = __hip_atomic_fetch_add(lcnt + e1, 1, __ATOMIC_RELAXED, __HIP_MEMORY_SCOPE_WORKGROUP);
        __syncthreads();
        if (tidx < 32) { const int c = lcnt[tidx]; lbase[tidx] = c ? atomicAdd(ctrl + C_FILL + tidx, c) : 0; }
        __syncthreads();
        const int row0 = lps[e0] + lbase[e0] + r0, row1 = lps[e1] + lbase[e1] + r1;
        stok[row0] = i0 >> 2; rdst[row0] = i0; rgate[row0] = tokg[i0]; rss[row0] = rnorm[i0 >> 2];
        stok[row1] = i1 >> 2; rdst[row1] = i1; rgate[row1] = tokg[i1]; rss[row1] = rnorm[i1 >> 2];
        __syncthreads();
        if (tidx < 32) lcnt[tidx] = 0;
        __syncthreads();
    }
}

__device__ __forceinline__ void phase_final(float* __restrict__ xo, const bf16_t* __restrict__ x1, const unsigned char* __restrict__ y, const float* __restrict__ gf) {
    typedef float f32x2_ __attribute__((ext_vector_type(2)));
    int tidx = threadIdx.x; asm volatile("" : "+v"(tidx));
    const int wid = __builtin_amdgcn_readfirstlane(tidx >> 6), lane = tidx & 63;
    for (int row = (int)blockIdx.x * 8 + wid; row < NTOK; row += (int)gridDim.x * 8) {
        float* xr = xo + (size_t)row * DM + 8 * lane; const bf16_t* x1r = x1 + (size_t)row * DM + 8 * lane; const unsigned char* yr = y + (size_t)row * 4 * DM + 8 * lane;
        f32x4 v[4]; u32x2 yw[4][2]; u32x4 xw[2];
#pragma unroll
        for (int hf = 0; hf < 2; ++hf) { xw[hf] = *(const u32x4*)(x1r + 512 * hf);
#pragma unroll
            for (int k = 0; k < 4; ++k) yw[k][hf] = *(const u32x2*)(yr + (size_t)k * DM + 512 * hf); }
        float ss = 0.f;
#pragma unroll
        for (int hf = 0; hf < 2; ++hf) { pg8::unpack8(xw[hf], v[2 * hf], v[2 * hf + 1]);
#pragma unroll
            for (int k = 0; k < 4; ++k) { const f32x2_ a = __builtin_amdgcn_cvt_pk_f32_fp8(yw[k][hf].x, false), b = __builtin_amdgcn_cvt_pk_f32_fp8(yw[k][hf].x, true), c = __builtin_amdgcn_cvt_pk_f32_fp8(yw[k][hf].y, false), d = __builtin_amdgcn_cvt_pk_f32_fp8(yw[k][hf].y, true);
                v[2 * hf][0] += a[0] * 0.125f; v[2 * hf][1] += a[1] * 0.125f; v[2 * hf][2] += b[0] * 0.125f; v[2 * hf][3] += b[1] * 0.125f;
                v[2 * hf + 1][0] += c[0] * 0.125f; v[2 * hf + 1][1] += c[1] * 0.125f; v[2 * hf + 1][2] += d[0] * 0.125f; v[2 * hf + 1][3] += d[1] * 0.125f; } }
#pragma unroll
        for (int i = 0; i < 4; ++i) ss += (v[i][0] * v[i][0] + v[i][1] * v[i][1]) + (v[i][2] * v[i][2] + v[i][3] * v[i][3]);
        ss = wave_sum(ss); const float r = rsqrtf(ss * (1.0f / DM) + 1e-5f);
#pragma unroll
        for (int hf = 0; hf < 2; ++hf) { const f32x4 g0 = *(const f32x4*)(gf + 8 * lane + 512 * hf), g1 = *(const f32x4*)(gf + 8 * lane + 512 * hf + 4);
            *(f32x4*)(xr + 512 * hf) = v[2 * hf] * r * g0; *(f32x4*)(xr + 512 * hf + 4) = v[2 * hf + 1] * r * g1; }
    }
}


#ifndef RPT_P0
#define RPT_P0 1
#endif
#ifndef RPT_INPROJ
#define RPT_INPROJ 1
#endif
#ifndef RPT_MIXA
#define RPT_MIXA 1
#endif
#ifndef RPT_MIXB
#define RPT_MIXB 1
#endif
#ifndef RPT_P3
#define RPT_P3 1
#endif
#ifndef RPT_MOE
#define RPT_MOE 1
#endif
#ifndef PHASE_MASK
#define PHASE_MASK 0xFF
#endif
constexpr int LDS_BYTES = 163840;
#define PHASE_LOOP(NX, NY, NZ, CALL) do { int tid = (int)(threadIdx.x & 255), half = (int)(threadIdx.x >> 8); asm volatile("" : "+v"(tid), "+v"(half)); for (int vb_ = (int)blockIdx.x * 2 + half; vb_ < (NX) * (NY) * (NZ); vb_ += (int)gridDim.x * 2) { \
    const int vbx = vb_ % (NX), vby = (vb_ / (NX)) % (NY), vbz = vb_ / ((NX) * (NY)); (void)vbx; (void)vby; (void)vbz; CALL; } } while (0)

__global__ __launch_bounds__(512, 2) void mega(Params p) {
    volatile LAS unsigned* xbw = (volatile LAS unsigned*)dyn_lds;
    if (threadIdx.x == 0) { xbw[0] = 0u; xbw[1] = 0u; xbw[2] = 0u; xbw[3] = 0u; }
    __syncthreads();
    char* ws = p.ws; float* out = p.out;
    XcdBarrier bar = xcd_barrier_post((unsigned*)(ws + WS_BAR), xbw);
    int* ctrl = (int*)(ws + WS_CTRL); float* rope = (float*)(ws + WS_ROPE);
    int* toke = (int*)(ws + WS_TOKE); float* tokg = (float*)(ws + WS_TOKG); int* stok = (int*)(ws + WS_STOK); int* rdst = (int*)(ws + WS_RDST); float* rgate = (float*)(ws + WS_RGATE);
    bf16_t* Win = (bf16_t*)(ws + WS_WIN); bf16_t* PA = (bf16_t*)(ws + WS_PA); bf16_t* PB = (bf16_t*)(ws + WS_PB); bf16_t* Wout = (bf16_t*)(ws + WS_WOUT);
    bf16_t* W1 = (bf16_t*)(ws + WS_W1); bf16_t* W2 = (bf16_t*)(ws + WS_W2);
    bf16_t* XN = (bf16_t*)(ws + WS_XN); bf16_t* OAB = (bf16_t*)(ws + WS_OAB); bf16_t* PROJ = (bf16_t*)(ws + WS_PROJ); bf16_t* MERGED = (bf16_t*)(ws + WS_MERGED);
    bf16_t* GATE = (bf16_t*)(ws + WS_GATE); bf16_t* H2 = (bf16_t*)(ws + WS_H2); bf16_t* ACT = (bf16_t*)(ws + WS_ACT); bf16_t* Y = (bf16_t*)(ws + WS_Y);
    for (int rp_ = 0; rp_ < RPT_P0; ++rp_) phase_p0(p, ws);
    xcd_barrier(bar);
    PG8_LAS unsigned char* ring = (PG8_LAS unsigned char*)dyn_lds + 1024;
    const int G = (int)gridDim.x, vcu = (G % 8 == 0) ? ((int)blockIdx.x % 8) * (G / 8) + (int)blockIdx.x / 8 : (int)blockIdx.x;
    for (int rp_ = 0; rp_ < RPT_INPROJ; ++rp_) { pg8::Gemm g{ws + WS_XN, ws + WS_WIN, nullptr, DM, DM, 0}; pg8::StaticOrder S; S.init(NTOK, 5120, G, (int)blockIdx.x);
      pg8::EpiInProjI e{pg8::EpiInProjF{PROJ, GATE, p.b_gate, rope}, (const float*)(ws + WS_SX), (const float*)(ws + WS_SWIN)};
      pg8::gemm_phase<pg8::EpiInProjI, pg8::StaticOrder, false, true, 1>(ring, g, S, e); }
    xcd_barrier(bar);
#ifdef GOLD_A
    if (PHASE_MASK & 4) PHASE_LOOP(NTOK * 8 / 4, 1, 1, b_attn_a_ref(vbx, vby, vbz, tid, PROJ, OAB));
#else
    for (int rp_ = 0; rp_ < RPT_MIXA; ++rp_) phase_mix_a(PROJ, OAB, rp_ + 1 < RPT_MIXA ? ABL_A : 0);
#endif
#ifdef GOLD_B
    if (PHASE_MASK & 8) PHASE_LOOP(NTOK * 8 / 4, 1, 1, b_attn_b_ref(vbx, vby, vbz, tid, PROJ, OAB));
#else
    for (int rp_ = 0; rp_ < RPT_MIXB; ++rp_) phase_mix_b(PROJ, OAB);
#endif
    xcd_barrier(bar);
    for (int rp_ = 0; rp_ < RPT_P3; ++rp_) { pg8::StaticOrder S; S.init(2 * NTOK, DM, G, (int)blockIdx.x);
      pg8::Gemm g{OAB, PA, nullptr, DM * 2, DM * 2, 0}; pg8::EpiProj2 e{(const unsigned char*)GATE, MERGED}; pg8::gemm_phase<pg8::EpiProj2, pg8::StaticOrder, false, true, 0, true>(ring, g, S, e); }
    xcd_barrier(bar);
    { pg8::Gemm g{MERGED, Wout, nullptr, DM * 2, DM * 2, 0}; pg8::StaticOrder S; S.init(NTOK, DM, G, (int)blockIdx.x); pg8::EpiWoutF e{p.x, (bf16_t*)(ws + WS_X1), p.norm2_g, (unsigned*)(ws + WS_AMAX)};
      pg8::gemm_phase<pg8::EpiWoutF, pg8::StaticOrder, false, true>(ring, g, S, e); }
    xcd_barrier(bar);
    float* rnorm = (float*)(ws + WS_RNORM);
    phase_router((const bf16_t*)(ws + WS_X1), p.norm2_g, p.w_router, p.b_router, (signed char*)H2, (const unsigned*)(ws + WS_AMAX), toke, tokg, rnorm, ctrl + C_CNT);
    xcd_barrier(bar);
    phase_assign(toke, tokg, rnorm, ctrl, stok, rdst, rgate, (float*)(ws + WS_RSS));
    xcd_barrier(bar);
    const int ntl = ctrl[C_NTILES];
#pragma unroll 1
    for (int ps_ = 0; ps_ < NPASS * RPT_MOE; ++ps_) { const int ps = ps_ % NPASS;
        const int t0 = ps * PASS_TILES; int T = ntl - t0; T = T < 0 ? 0 : (T > PASS_TILES ? PASS_TILES : T);
        if (T == 0) continue;
        { pg8::Gemm g{H2, W1, stok, DM, DM, 2048}; pg8::MoeOrder S{t0, T, 8, G, vcu, ctrl + C_TILEE}; pg8::EpiMoe1I e{ACT, p.b1, (const float*)(ws + WS_RSS), (const float*)(ws + WS_SW1), t0, 0};
          pg8::gemm_phase<pg8::EpiMoe1I, pg8::MoeOrder, true, true, 1>(ring, g, S, e); }
        xcd_barrier(bar);
        { pg8::Gemm g{(const unsigned char*)ACT - (size_t)t0 * 256 * DM, W2, nullptr, DM, DM, 1024}; pg8::MoeOrder S{t0, T, 4, G, vcu, ctrl + C_TILEE}; pg8::EpiMoe2F e{Y, p.b2, rdst, rgate, (const float*)(ws + WS_SW2)};
          pg8::gemm_phase<pg8::EpiMoe2F, pg8::MoeOrder, false, true, 2>(ring, g, S, e); }
        xcd_barrier(bar);
    }
    phase_final(out, (const bf16_t*)(ws + WS_X1), (const unsigned char*)Y, p.norm_f_g);
}

extern "C" void kernel_launch(void* const* d_in, const int* in_sizes, int n_in, void* d_out, int out_size, void* d_ws, size_t ws_size, hipStream_t stream) {
    if (ws_size < WS_NEED) { fprintf(stderr, "workspace too small: %zu < %zu\n", ws_size, (size_t)WS_NEED); return; }
    static int grid = 0;
    if (!grid) {
        int dev = 0, cus = 0, per_cu = 0; (void)hipGetDevice(&dev); (void)hipDeviceGetAttribute(&cus, hipDeviceAttributeMultiprocessorCount, dev);
        (void)hipFuncSetAttribute((const void*)mega, hipFuncAttributeMaxDynamicSharedMemorySize, LDS_BYTES);
        (void)hipOccupancyMaxActiveBlocksPerMultiprocessor(&per_cu, (const void*)mega, 512, LDS_BYTES);
        if (per_cu < 1) { fprintf(stderr, "mega: occupancy query says %d blocks per CU\n", per_cu); per_cu = 1; }
        grid = cus;
    }
    char* ws = (char*)d_ws;
    (void)hipMemsetAsync(ws, 0, 128 * 1024, stream);
    Params p{};
    p.x = (const float*)d_in[0]; p.norm1_g = (const float*)d_in[1]; p.w_in = (const float*)d_in[2]; p.w_proj_a = (const float*)d_in[3]; p.w_proj_b = (const float*)d_in[4];
    p.w_gate = (const float*)d_in[5]; p.b_gate = (const float*)d_in[6]; p.w_out = (const float*)d_in[7]; p.norm2_g = (const float*)d_in[8]; p.w_router = (const float*)d_in[9];
    p.b_router = (const float*)d_in[10]; p.w1 = (const float*)d_in[11]; p.b1 = (const float*)d_in[12]; p.w2 = (const float*)d_in[13]; p.b2 = (const float*)d_in[14]; p.norm_f_g = (const float*)d_in[15];
    p.out = (float*)d_out; p.ws = ws;
    for (int j = 0; j < 8; ++j) p.fr.f[j] = (float)pow(500000.0, -(double)j / 8.0);
    hipLaunchKernelGGL(mega, dim3(grid), dim3(512), LDS_BYTES, stream, p);
}
```
